# Optimizing an MI355X kernel written in HIP

```python
import math
import jax, jax.numpy as jnp
from jax import lax
import numpy as np

D_MODEL = 4096
BATCH = 1
SEQ = 8192
DEPTH = 1
DEC_BATCH = 128
DEC_SEQ = 4
PAST_LEN = 8192
PAGE_SIZE = 128

MIX_WIDTH = D_MODEL
GLA_WIDTH = MIX_WIDTH // 2
SWA_WIDTH = MIX_WIDTH - GLA_WIDTH
GLA_HEADS = 4
GLA_DV = GLA_WIDTH // GLA_HEADS
GLA_DK = GLA_DV // 2
GLA_QK = GLA_HEADS * GLA_DK
GLA_LR = 16
GLA_TAU = 16.0
GLA_CHUNK = 64
HEAD_DIM = 128
SWA_HEADS = SWA_WIDTH // HEAD_DIM
SWA_KV_HEADS = 4
SWA_GROUP = SWA_HEADS // SWA_KV_HEADS
SWA_Q = SWA_HEADS * HEAD_DIM
SWA_KV = SWA_KV_HEADS * HEAD_DIM
WINDOW = 128
D_FF = 256 * ((8 * D_MODEL // 3 + 255) // 256)
CONV_W = 3
NORM_EPS = 1e-6
NEG_INF = -1e30
IN_SIZES = (GLA_QK, GLA_QK, GLA_WIDTH, GLA_WIDTH, GLA_LR, SWA_Q, SWA_KV, SWA_KV)
IN_WIDTH = sum(IN_SIZES)

kernel_name = "hymba_gla_swa_sink_convffn_adaln_step"


def rmsnorm(x, g):
    xf = x.astype(jnp.float32)
    y = xf * lax.rsqrt(jnp.mean(xf * xf, axis=-1, keepdims=True) + NORM_EPS)
    return (y * g.astype(jnp.float32)).astype(x.dtype)


def alibi_slopes():
    return jnp.exp2(-8.0 * jnp.arange(1, SWA_HEADS + 1, dtype=jnp.float32) / SWA_HEADS)


def gla_chunked(q, k, v, log_a, s0):
    B, L, H, dk = q.shape
    dv = v.shape[-1]
    C = math.gcd(L, GLA_CHUNK)
    NC = L // C
    f32 = jnp.float32
    q = q.astype(f32).reshape(B, NC, C, H, dk)
    k = k.astype(f32).reshape(B, NC, C, H, dk)
    v = v.astype(f32).reshape(B, NC, C, H, dv)
    b = jnp.cumsum(log_a.astype(f32).reshape(B, NC, C, H, dk), axis=2)
    qg = q * jnp.exp(b)
    kg = k * jnp.exp(-b)
    causal = jnp.tril(jnp.ones((C, C), dtype=bool))
    A = jnp.einsum('bnthk,bnshk->bnhts', qg, kg)
    A = jnp.where(causal, A, 0.0)
    o_intra = jnp.einsum('bnhts,bnshv->bnthv', A, v)
    b_last = b[:, :, -1]
    kd = k * jnp.exp(b_last[:, :, None] - b)
    dS = jnp.einsum('bnshk,bnshv->bnhkv', kd, v)
    decay = jnp.exp(b_last)

    def step(S, xs):
        qg_n, dS_n, dec_n = xs
        o_n = jnp.einsum('bthk,bhkv->bthv', qg_n, S)
        S = dec_n[..., None] * S + dS_n
        return S, o_n

    xs = (jnp.moveaxis(qg, 1, 0), jnp.moveaxis(dS, 1, 0), jnp.moveaxis(decay, 1, 0))
    s_final, o_inter = lax.scan(step, s0.astype(f32), xs)
    o = o_intra + jnp.moveaxis(o_inter, 0, 1)
    return o.reshape(B, L, H, dv), s_final.astype(s0.dtype)


def sink_attention(q, k, v, dist, valid, sinks):
    slopes = alibi_slopes().reshape(SWA_KV_HEADS, SWA_GROUP)
    s = jnp.einsum('bnqhgd,bnkhd->bnhgqk', q, k,
                   preferred_element_type=jnp.float32) * (HEAD_DIM ** -0.5)
    s = s - slopes[None, None, :, :, None, None] * dist[None, :, None, None]
    s = jnp.where(valid[None, :, None, None], s, NEG_INF)
    sink = jnp.broadcast_to(
        sinks.astype(jnp.float32).reshape(SWA_KV_HEADS, SWA_GROUP)[None, None, :, :, None, None],
        s.shape[:-1] + (1,))
    p = jax.nn.softmax(jnp.concatenate([s, sink], axis=-1), axis=-1)[..., :-1]
    return jnp.einsum('bnhgqk,bnkhd->bnqhgd', p.astype(v.dtype), v)


def swa_prompt(q, k, v, sinks):
    B, L = q.shape[:2]
    W = WINDOW
    NB = L // W
    qb = q.reshape(B, NB, W, SWA_KV_HEADS, SWA_GROUP, HEAD_DIM)
    pad = jnp.zeros((B, W, SWA_KV_HEADS, HEAD_DIM), k.dtype)
    def band(t):
        prev = jnp.concatenate([pad, t], axis=1)[:, :L].reshape(B, NB, W, SWA_KV_HEADS, HEAD_DIM)
        cur = t.reshape(B, NB, W, SWA_KV_HEADS, HEAD_DIM)
        return jnp.concatenate([prev, cur], axis=2)
    kb, vb = band(k), band(v)
    blk = jnp.arange(NB)[:, None, None]
    q_pos = blk * W + jnp.arange(W)[None, :, None]
    k_pos = (blk - 1) * W + jnp.arange(2 * W)[None, None, :]
    d = q_pos - k_pos
    valid = (d >= 0) & (d <= WINDOW) & (k_pos >= 0)
    o = sink_attention(qb, kb, vb, d.astype(jnp.float32), valid, sinks)
    return o.reshape(B, L, SWA_KV_HEADS, SWA_GROUP, HEAD_DIM)


def swa_sample(q, k, v, k_buf, v_buf, sinks):
    L = q.shape[1]
    wb = k_buf.shape[1]
    kc = jnp.concatenate([k_buf.astype(k.dtype), k], axis=1)
    vc = jnp.concatenate([v_buf.astype(v.dtype), v], axis=1)
    k_pos = PAST_LEN - wb + jnp.arange(wb + L)
    q_pos = PAST_LEN + jnp.arange(L)
    d = (q_pos[:, None] - k_pos[None, :])[None]
    valid = (d >= 0) & (d <= WINDOW) & (k_pos[None, None, :] >= 0)
    o = sink_attention(q[:, None], kc[:, None], vc[:, None], d.astype(jnp.float32), valid, sinks)
    return o[:, 0], kc[:, -wb:], vc[:, -wb:]


def trunk_layer(x, c, lp, s0, kv_buf, conv_buf):
    (w_ada, b_ada, g_norm, w_in, w_a_up, b_a, g_gla, swa_sinks,
     w_o, w_up, w_conv, b_conv, w_down) = lp
    B, L, _ = x.shape
    mod = jax.nn.silu(c) @ w_ada + b_ada
    sh1, sc1, gt1, sh2, sc2, gt2 = jnp.split(mod, 6, axis=-1)

    h = rmsnorm(x, g_norm[0]) * (1.0 + sc1[:, None]) + sh1[:, None]
    proj = h @ w_in
    offs = []
    acc = 0
    for sz in IN_SIZES[:-1]:
        acc += sz
        offs.append(acc)
    gq, gk, gv, gr, ga, sq, sk, sv = jnp.split(proj, offs, axis=-1)

    log_a = jax.nn.log_sigmoid((ga @ w_a_up + b_a).astype(jnp.float32)) / GLA_TAU
    o_gla, s_new = gla_chunked(
        gq.reshape(B, L, GLA_HEADS, GLA_DK) * (GLA_DK ** -0.5),
        gk.reshape(B, L, GLA_HEADS, GLA_DK),
        gv.reshape(B, L, GLA_HEADS, GLA_DV),
        log_a.reshape(B, L, GLA_HEADS, GLA_DK), s0)
    o_gla = rmsnorm(o_gla, g_gla) * jax.nn.silu(gr.reshape(B, L, GLA_HEADS, GLA_DV))

    q = sq.reshape(B, L, SWA_KV_HEADS, SWA_GROUP, HEAD_DIM)
    k = sk.reshape(B, L, SWA_KV_HEADS, HEAD_DIM)
    v = sv.reshape(B, L, SWA_KV_HEADS, HEAD_DIM)
    if kv_buf is None:
        o_swa = swa_prompt(q, k, v, swa_sinks)
        wp = min(WINDOW, L)
        kb_new, vb_new = k[:, L - wp:], v[:, L - wp:]
    else:
        o_swa, kb_new, vb_new = swa_sample(q, k, v, kv_buf[0], kv_buf[1], swa_sinks)

    mix = jnp.concatenate([o_gla.reshape(B, L, GLA_WIDTH).astype(x.dtype),
                           o_swa.reshape(B, L, SWA_WIDTH).astype(x.dtype)], axis=-1)
    x = x + gt1[:, None] * (mix @ w_o)

    h2 = rmsnorm(x, g_norm[1]) * (1.0 + sc2[:, None]) + sh2[:, None]
    u = h2 @ w_up
    ue = jnp.concatenate([conv_buf.astype(u.dtype), u], axis=1)
    uc = b_conv
    for j in range(CONV_W):
        uc = uc + w_conv[j] * ue[:, j:j + L]
    gate, val = jnp.split(uc, 2, axis=-1)
    x = x + gt2[:, None] * ((jax.nn.silu(gate) * val) @ w_down)
    conv_new = ue[:, -(CONV_W - 1):]
    return x, s_new, kb_new, vb_new, conv_new


def setup_inputs(seed: int = 0) -> dict:
    key = jax.random.key(seed)
    ks = jax.random.split(key, 32)
    nrm = lambda k, shape, s: jax.random.normal(k, shape, jnp.float32) * s
    wb = min(WINDOW, PAST_LEN)
    F2 = 2 * D_FF
    return {
        "x_prompt": nrm(ks[0], (BATCH, SEQ, D_MODEL), 1.0),
        "x_sample": nrm(ks[1], (DEC_BATCH, DEC_SEQ, D_MODEL), 1.0),
        "c_prompt": nrm(ks[2], (BATCH, D_MODEL), 1.0),
        "c_sample": nrm(ks[3], (DEC_BATCH, D_MODEL), 1.0),
        "state_gla": nrm(ks[4], (DEPTH, DEC_BATCH, GLA_HEADS, GLA_DK, GLA_DV), 0.5),
        "state_swa_k": nrm(ks[5], (DEPTH, DEC_BATCH, wb, SWA_KV_HEADS, HEAD_DIM), 1.0),
        "state_swa_v": nrm(ks[6], (DEPTH, DEC_BATCH, wb, SWA_KV_HEADS, HEAD_DIM), 1.0),
        "state_ffn_conv": nrm(ks[7], (DEPTH, DEC_BATCH, CONV_W - 1, F2), 1.0),
        "w_ada": nrm(ks[8], (DEPTH, D_MODEL, 6 * D_MODEL), D_MODEL ** -0.5),
        "b_ada": nrm(ks[9], (DEPTH, 6 * D_MODEL), 0.02),
        "g_norm": 1.0 + nrm(ks[10], (DEPTH, 2, D_MODEL), 0.02),
        "w_in": nrm(ks[11], (DEPTH, D_MODEL, IN_WIDTH), D_MODEL ** -0.5),
        "w_a_up": nrm(ks[12], (DEPTH, GLA_LR, GLA_QK), GLA_LR ** -0.5),
        "b_a": nrm(ks[13], (DEPTH, GLA_QK), 0.1),
        "g_gla": 1.0 + nrm(ks[14], (DEPTH, GLA_DV), 0.02),
        "swa_sinks": nrm(ks[15], (DEPTH, SWA_HEADS), 0.5),
        "w_o": nrm(ks[16], (DEPTH, MIX_WIDTH, D_MODEL), MIX_WIDTH ** -0.5),
        "w_up": nrm(ks[17], (DEPTH, D_MODEL, F2), D_MODEL ** -0.5),
        "w_conv": nrm(ks[18], (DEPTH, CONV_W, F2), CONV_W ** -0.5),
        "b_conv": nrm(ks[19], (DEPTH, F2), 0.02),
        "w_down": nrm(ks[20], (DEPTH, D_FF, D_MODEL), D_FF ** -0.5),
        "g_final": 1.0 + nrm(ks[21], (D_MODEL,), 0.02),
    }


def reference(x_prompt, x_sample, c_prompt, c_sample, state_gla, state_swa_k, state_swa_v,
              state_ffn_conv, w_ada, b_ada, g_norm, w_in, w_a_up, b_a, g_gla, swa_sinks,
              w_o, w_up, w_conv, b_conv, w_down, g_final):
    yp, ys = x_prompt, x_sample
    Bp = x_prompt.shape[0]
    gla_p, kp, vp, cp = [], [], [], []
    gla_s, kss, vss, cs = [], [], [], []
    for l in range(DEPTH):
        lp = (w_ada[l], b_ada[l], g_norm[l], w_in[l], w_a_up[l], b_a[l], g_gla[l],
              swa_sinks[l], w_o[l], w_up[l], w_conv[l], b_conv[l], w_down[l])
        s0_p = jnp.zeros((Bp, GLA_HEADS, GLA_DK, GLA_DV), state_gla.dtype)
        conv0_p = jnp.zeros((Bp, CONV_W - 1, 2 * D_FF), state_ffn_conv.dtype)
        yp, s_p, k_p, v_p, c_p = trunk_layer(yp, c_prompt, lp, s0_p, None, conv0_p)
        ys, s_s, k_s, v_s, c_s = trunk_layer(ys, c_sample, lp, state_gla[l],
                                             (state_swa_k[l], state_swa_v[l]), state_ffn_conv[l])
        gla_p.append(s_p); kp.append(k_p); vp.append(v_p); cp.append(c_p)
        gla_s.append(s_s); kss.append(k_s); vss.append(v_s); cs.append(c_s)
    y_prompt = rmsnorm(yp, g_final)
    y_sample = rmsnorm(ys, g_final)
    return (y_prompt, y_sample,
            jnp.stack(gla_p), jnp.stack(kp), jnp.stack(vp), jnp.stack(cp),
            jnp.stack(gla_s), jnp.stack(kss), jnp.stack(vss), jnp.stack(cs))
```

```cpp
#include <hip/hip_runtime.h>
#include <cstdio>
#include <cstdint>
namespace pg8 {
#define PG8_LAS __attribute__((address_space(3)))
typedef unsigned short bf16_t;
typedef short bf16x8 __attribute__((ext_vector_type(8)));
typedef float f32x4 __attribute__((ext_vector_type(4)));
typedef unsigned u32x4 __attribute__((ext_vector_type(4)));
constexpr int BM = 256, BK = 64, HALF = 128, HTB = HALF * BK * 2  , STAGE_BYTES = 8 * HTB, NXCD = 8, WGM = 8;

__host__ __device__ __forceinline__ int lds_byte(int r, int c) { const int st = (r >> 4) * 2 + (c >> 5), rr = r & 15, cc = c & 31, ob = rr * 64 + cc * 2; return st * 1024 + (ob ^ (((ob >> 9) & 1) << 5)); }
__host__ __device__ __forceinline__ void stage_rc(int b, int& R, int& C) { const int st = b / 1024, sb = b % 1024, swz = sb ^ (((sb >> 9) & 1) << 5); R = (st >> 1) * 16 + swz / 64; C = (st & 1) * 32 + (swz % 64) / 2; }
__host__ __device__ __forceinline__ int perm32(int rho) { const int n = rho >> 4, i = rho & 15; return 8 * (i >> 2) + 4 * n + (i & 3); }

struct Unit { int pm, pn, kt0, nt; };
struct Gemm { const bf16_t* A; const bf16_t* Bt; int M, N, K; };

struct StaticOrder {
    int nM, nN, nwg, G, c, ntk;
    __host__ __device__ void init(int M, int N, int G_, int c_, int K) { nM = M / BM; nN = N / BM; nwg = nM * nN; G = G_; c = c_; ntk = K / BK; }
    __host__ __device__ bool next(int i, Unit& u) const {
        const long L = (long)i * G + c; if (L >= nwg) return false;
        int wgid = (int)L; { const int q = nwg / NXCD, r = nwg % NXCD, xcd = wgid % NXCD, off = wgid / NXCD; wgid = (xcd < r ? xcd * (q + 1) : r * (q + 1) + (xcd - r) * q) + off; }
        const int nig = WGM * nN, gid = wgid / nig, fm = gid * WGM, gsz = (nM - fm) < WGM ? (nM - fm) : WGM;
        u.pm = fm + ((wgid % nig) % gsz); u.pn = (wgid % nig) / gsz; u.kt0 = 0; u.nt = ntk; return true;
    }
    __device__ __forceinline__ void a_ready(const Unit&) const {}
    __device__ __forceinline__ void done(const Unit&) const {}
};

typedef float f32x2_t __attribute__((ext_vector_type(2)));
typedef __bf16 bf16x2_t __attribute__((ext_vector_type(2)));
__device__ __forceinline__ unsigned cvt_pk_bf16(float lo, float hi) { const f32x2_t v = {lo, hi}; return __builtin_bit_cast(unsigned, __builtin_convertvector(v, bf16x2_t)); }

struct RowOrder {
    int n, c, ntk;
    __device__ __forceinline__ bool next(int i, Unit& u) const { if (i > 0 || c >= n) return false; u.pm = 0; u.pn = c; u.kt0 = 0; u.nt = ntk; return true; }
    __device__ __forceinline__ void a_ready(const Unit&) const {}
    __device__ __forceinline__ void done(const Unit&) const {}
};

struct TailOrder {
    StaticOrder P; int G, c, nd;
    __device__ __forceinline__ void init(int G_, int c_, int K) { P.init(8192, 4096, G_, c_, K); G = G_; c = c_; nd = K / 128; }
    __device__ __forceinline__ bool next(int i, Unit& u) const {
        const long L = (long)i * G + c;
        if (L < 512) return P.next(i, u);
        if (L >= 768) return false;
        const int su = (int)L - 512, ks = su >> 5, base = nd >> 3, rem = nd & 7;
        u.pn = su & 15; u.pm = 32 + ((su >> 4) & 1);
        u.kt0 = 2 * (ks * base + (ks < rem ? ks : rem)); u.nt = 2 * (base + (ks < rem ? 1 : 0));
        return true;
    }
    __device__ __forceinline__ void a_ready(const Unit&) const {}
    __device__ __forceinline__ void done(const Unit&) const {}
};

struct EpiF32 {
    static constexpr bool PERM = false, AFTER_DRAIN = false;
    float* C; int ldc; const float* bias;
    __device__ __forceinline__ void operator()(const f32x4 (&acc)[2][2][4][2], const Unit& u, int wr, int wc, int fr, int fq) const {
        const int row0 = u.pm * BM + wr * 64 + fr, col0 = u.pn * BM + wc * 32 + 4 * fq;
        f32x4 bv[2][2];
#pragma unroll
        for (int bj = 0; bj < 2; ++bj)
#pragma unroll
            for (int n = 0; n < 2; ++n) bv[bj][n] = *(const f32x4*)(bias + col0 + bj * HALF + n * 16);
#pragma unroll
        for (int ai = 0; ai < 2; ++ai)
#pragma unroll
            for (int m = 0; m < 4; ++m) { float* rowp = C + (size_t)(row0 + ai * HALF + m * 16) * ldc + col0;
#pragma unroll
                for (int bj = 0; bj < 2; ++bj)
#pragma unroll
                    for (int n = 0; n < 2; ++n) *(f32x4*)(rowp + bj * HALF + n * 16) = acc[ai][bj][m][n] + bv[bj][n]; }
    }
};
struct EpiBf16 {
    static constexpr bool PERM = true, AFTER_DRAIN = false;
    bf16_t* O; int ldc;
    __device__ __forceinline__ void operator()(const f32x4 (&acc)[2][2][4][2], const Unit& u, int wr, int wc, int fr, int fq) const {
        const int row0 = u.pm * BM + wr * 64 + fr, col0 = u.pn * BM + wc * 32 + 8 * fq;
#pragma unroll
        for (int ai = 0; ai < 2; ++ai)
#pragma unroll
            for (int m = 0; m < 4; ++m) { bf16_t* rowp = O + (size_t)(row0 + ai * HALF + m * 16) * ldc + col0;
#pragma unroll
                for (int bj = 0; bj < 2; ++bj) { const f32x4 v0 = acc[ai][bj][m][0], v1 = acc[ai][bj][m][1];
                    u32x4 w; w.x = cvt_pk_bf16(v0[0], v0[1]); w.y = cvt_pk_bf16(v0[2], v0[3]); w.z = cvt_pk_bf16(v1[0], v1[1]); w.w = cvt_pk_bf16(v1[2], v1[3]);
                    *(u32x4*)(rowp + bj * HALF) = w; } }
    }
};
template <bool BASE_BF16> struct EpiResid {
    static constexpr bool PERM = true, AFTER_DRAIN = false;
    const void* bp; const float* gate; bf16_t* out; float* slab; int nd;
    __device__ __forceinline__ void operator()(const f32x4 (&acc)[2][2][4][2], const Unit& u, int wr, int wc, int fr, int fq) const {
        const int row0 = u.pm * BM + wr * 64 + fr, col0 = u.pn * BM + wc * 32 + 8 * fq;
        if (u.pm < 32) {
            const float* grow = gate + (size_t)128 * 24576 + col0;
            f32x4 gv[2][2];
#pragma unroll
            for (int bj = 0; bj < 2; ++bj) { gv[bj][0] = *(const f32x4*)(grow + bj * HALF); gv[bj][1] = *(const f32x4*)(grow + bj * HALF + 4); }
            if (BASE_BF16) {
                u32x4 b[2][4][2];
#pragma unroll
                for (int ai = 0; ai < 2; ++ai)
#pragma unroll
                    for (int m = 0; m < 4; ++m)
#pragma unroll
                        for (int bj = 0; bj < 2; ++bj) b[ai][m][bj] = *(const u32x4*)((const bf16_t*)bp + (size_t)(row0 + ai * HALF + m * 16) * 4096 + col0 + bj * HALF);
#pragma unroll
                for (int ai = 0; ai < 2; ++ai)
#pragma unroll
                    for (int m = 0; m < 4; ++m)
#pragma unroll
                        for (int bj = 0; bj < 2; ++bj) { const u32x4 q = b[ai][m][bj];
                            const f32x4 x0 = (f32x4){__uint_as_float(q.x << 16), __uint_as_float(q.x & 0xffff0000u), __uint_as_float(q.y << 16), __uint_as_float(q.y & 0xffff0000u)};
                            const f32x4 x1 = (f32x4){__uint_as_float(q.z << 16), __uint_as_float(q.z & 0xffff0000u), __uint_as_float(q.w << 16), __uint_as_float(q.w & 0xffff0000u)};
                            const f32x4 v0 = x0 + gv[bj][0] * acc[ai][bj][m][0], v1 = x1 + gv[bj][1] * acc[ai][bj][m][1];
                            u32x4 w; w.x = cvt_pk_bf16(v0[0], v0[1]); w.y = cvt_pk_bf16(v0[2], v0[3]); w.z = cvt_pk_bf16(v1[0], v1[1]); w.w = cvt_pk_bf16(v1[2], v1[3]);
                            *(u32x4*)(out + (size_t)(row0 + ai * HALF + m * 16) * 4096 + col0 + bj * HALF) = w; }
            } else {
#pragma unroll
                for (int ai = 0; ai < 2; ++ai) {
                    f32x4 x[4][2][2];
#pragma unroll
                    for (int m = 0; m < 4; ++m)
#pragma unroll
                        for (int bj = 0; bj < 2; ++bj) { const float* p = (const float*)bp + (size_t)(row0 + ai * HALF + m * 16) * 4096 + col0 + bj * HALF; x[m][bj][0] = *(const f32x4*)p; x[m][bj][1] = *(const f32x4*)(p + 4); }
#pragma unroll
                    for (int m = 0; m < 4; ++m)
#pragma unroll
                        for (int bj = 0; bj < 2; ++bj) {
                            const f32x4 v0 = x[m][bj][0] + gv[bj][0] * acc[ai][bj][m][0], v1 = x[m][bj][1] + gv[bj][1] * acc[ai][bj][m][1];
                            u32x4 w; w.x = cvt_pk_bf16(v0[0], v0[1]); w.y = cvt_pk_bf16(v0[2], v0[3]); w.z = cvt_pk_bf16(v1[0], v1[1]); w.w = cvt_pk_bf16(v1[2], v1[3]);
                            *(u32x4*)(out + (size_t)(row0 + ai * HALF + m * 16) * 4096 + col0 + bj * HALF) = w; }
                }
            }
        } else {
            float* sl = slab + (size_t)((4 * u.kt0 + 7) / nd) * 512 * 4096;
#pragma unroll
            for (int ai = 0; ai < 2; ++ai)
#pragma unroll
                for (int m = 0; m < 4; ++m) { float* orow = sl + (size_t)(row0 + ai * HALF + m * 16 - 8192) * 4096 + col0;
#pragma unroll
                    for (int bj = 0; bj < 2; ++bj) { *(f32x4*)(orow + bj * HALF) = acc[ai][bj][m][0]; *(f32x4*)(orow + bj * HALF + 4) = acc[ai][bj][m][1]; } }
        }
    }
};

template <class Epi, class Sched, bool ALIGN_EPI = false, bool SP2 = false>
__device__ __forceinline__ void gemm_phase(PG8_LAS unsigned char* lds, const Gemm g, const Sched& S, const Epi& E) {
    const int tid = threadIdx.x, wid = __builtin_amdgcn_readfirstlane(tid >> 6), lane = tid & 63, wr = wid >> 2, wc = wid & 3, fr = lane & 15, fq = lane >> 4;
    const int K = g.K;
    unsigned voffA[2], voffB[2];
#pragma unroll
    for (int i = 0; i < 2; ++i) { int R, C; stage_rc(tid * 16 + i * 8192, R, C); const int Rb = Epi::PERM ? ((R & ~31) + perm32(R & 31)) : R;
        voffA[i] = (unsigned)(R * K + C) * 2u; (void)Rb; voffB[i] = (unsigned)(tid * 16 + i * 8192); }
    const size_t kstep = (size_t)(BK * 2);
    const size_t kstepB = (size_t)HTB;
    static_assert(Epi::PERM, "the pre-tiled weight copies carry the PERM row order");
    const size_t hstep = (size_t)HALF * K * 2;
    const size_t tstep = 2 * hstep;
    const unsigned ldsw = (unsigned)wid * 1024u;
    const int aoff = lds_byte(wr * 64 + fr, fq * 8), boff = lds_byte(wc * 32 + fr, fq * 8);
#define PG8_SA(b, h) (((b) * 2 + (h)) * HTB)
#define PG8_SB(b, h) ((4 + (b) * 2 + (h)) * HTB)
#define PG8_STAGE(bufoff, gbase, voff) do { _Pragma("unroll") for (int _i = 0; _i < 2; ++_i) \
        __builtin_amdgcn_global_load_lds((const unsigned*)((const char*)(gbase) + (voff)[_i]), (PG8_LAS unsigned*)(lds + (bufoff) + ldsw + _i * 8192), 16, 0, 0); } while (0)
#define PG8_LDA(dst, b, h) do { _Pragma("unroll") for (int m = 0; m < 4; ++m) _Pragma("unroll") for (int k = 0; k < 2; ++k) dst[m][k] = *(const PG8_LAS bf16x8*)(lds + PG8_SA(b, h) + aoff + m * 2048 + k * 1024); } while (0)
#define PG8_LDB(dst, b, h) do { _Pragma("unroll") for (int n = 0; n < 2; ++n) _Pragma("unroll") for (int k = 0; k < 2; ++k) dst[n][k] = *(const PG8_LAS bf16x8*)(lds + PG8_SB(b, h) + boff + n * 2048 + k * 1024); } while (0)
#define PG8_MMA(ai, bj, At, Bt) do { __builtin_amdgcn_s_setprio(1); _Pragma("unroll") for (int m = 0; m < 4; ++m) _Pragma("unroll") for (int n = 0; n < 2; ++n) _Pragma("unroll") for (int k = 0; k < 2; ++k) \
        acc[ai][bj][m][n] = __builtin_amdgcn_mfma_f32_16x16x32_bf16(Bt[n][k], At[m][k], acc[ai][bj][m][n], 0, 0, 0); __builtin_amdgcn_s_setprio(0); } while (0)
#define PG8_WAIT_V(n) asm volatile("s_waitcnt vmcnt(" #n ")" ::: "memory")
#define PG8_WAIT_L(n) asm volatile("s_waitcnt lgkmcnt(" #n ")" ::: "memory")
#define PG8_BAR __builtin_amdgcn_s_barrier()
#define PG8_SCHED __builtin_amdgcn_sched_barrier(0)
    Unit cur, nxt; int ui = 0;
    if (!S.next(0, cur)) return;
    int nt = cur.nt;
    f32x4 acc[2][2][4][2];
#pragma unroll
    for (int a = 0; a < 2; ++a)
#pragma unroll
        for (int b = 0; b < 2; ++b)
#pragma unroll
            for (int m = 0; m < 4; ++m)
#pragma unroll
                for (int n = 0; n < 2; ++n) acc[a][b][m][n] = (f32x4){0.f, 0.f, 0.f, 0.f};
    bf16x8 At[4][2], B0[2][2], B1[2][2];
    const char* cA = (const char*)g.A + (size_t)cur.pm * tstep + (size_t)cur.kt0 * kstep; const char* cB = (const char*)g.Bt + (size_t)cur.pn * tstep + (size_t)cur.kt0 * kstepB;
    S.a_ready(cur);
    if constexpr (SP2) {
        PG8_STAGE(PG8_SB(0, 0), cB, voffB); PG8_STAGE(PG8_SB(0, 1), cB + hstep, voffB); PG8_STAGE(PG8_SA(0, 0), cA, voffA); PG8_STAGE(PG8_SA(0, 1), cA + hstep, voffA);
        if (wr == 1) PG8_BAR;
        PG8_WAIT_V(2); PG8_BAR;
        PG8_STAGE(PG8_SB(1, 0), cB + kstepB, voffB); PG8_STAGE(PG8_SA(1, 0), cA + kstep, voffA); PG8_STAGE(PG8_SB(1, 1), cB + hstep + kstepB, voffB);
        PG8_WAIT_V(6); PG8_BAR;
    } else {
        PG8_STAGE(PG8_SB(0, 0), cB, voffB); PG8_STAGE(PG8_SA(0, 0), cA, voffA); PG8_STAGE(PG8_SB(0, 1), cB + hstep, voffB); PG8_STAGE(PG8_SA(0, 1), cA + hstep, voffA);
        if (wr == 1) PG8_BAR;
        PG8_WAIT_V(4); PG8_BAR;
        PG8_STAGE(PG8_SB(1, 0), cB + kstepB, voffB); PG8_STAGE(PG8_SA(1, 0), cA + kstep, voffA); PG8_STAGE(PG8_SB(1, 1), cB + hstep + kstepB, voffB);
        PG8_WAIT_V(6); PG8_BAR;
    }
    for (;;) {
        const bool has_next = S.next(ui + 1, nxt);
        const char* nA = has_next ? (const char*)g.A + (size_t)nxt.pm * tstep + (size_t)nxt.kt0 * kstep : cA; const char* nB = has_next ? (const char*)g.Bt + (size_t)nxt.pn * tstep + (size_t)nxt.kt0 * kstepB : cB;
        for (int t = 0; t < nt; t += 2) {
            const bool last = (t == nt - 2);
            const char* a1 = cA + (size_t)(t + 1) * kstep;
            const char* a2 = last ? nA : cA + (size_t)(t + 2) * kstep; const char* b2 = last ? nB : cB + (size_t)(t + 2) * kstepB;
            const char* a3 = a2 + kstep; const char* b3 = b2 + kstepB;
            if (last && has_next) S.a_ready(nxt);
            if constexpr (SP2) {
            PG8_LDB(B0, 0, 0); PG8_LDB(B1, 0, 1); PG8_SCHED; PG8_LDA(At, 0, 0); PG8_STAGE(PG8_SA(1, 1), a1 + hstep, voffA);
            PG8_WAIT_V(8); PG8_WAIT_L(0); PG8_BAR; PG8_MMA(0, 0, At, B0); PG8_MMA(0, 1, At, B1); PG8_BAR; PG8_SCHED;
            PG8_LDA(At, 0, 1); PG8_STAGE(PG8_SB(0, 0), b2, voffB); PG8_STAGE(PG8_SB(0, 1), b2 + hstep, voffB); PG8_STAGE(PG8_SA(0, 0), a2, voffA);
            PG8_WAIT_V(8); PG8_WAIT_L(0); PG8_BAR; PG8_MMA(1, 0, At, B0); PG8_MMA(1, 1, At, B1); PG8_BAR; PG8_SCHED;
            PG8_LDB(B0, 1, 0); PG8_LDB(B1, 1, 1); PG8_SCHED; PG8_LDA(At, 1, 0); PG8_STAGE(PG8_SA(0, 1), a2 + hstep, voffA);
            PG8_WAIT_V(8); PG8_WAIT_L(0); PG8_BAR; PG8_MMA(0, 0, At, B0); PG8_MMA(0, 1, At, B1); PG8_BAR; PG8_SCHED;
            PG8_LDA(At, 1, 1); PG8_STAGE(PG8_SB(1, 0), b3, voffB); PG8_STAGE(PG8_SB(1, 1), b3 + hstep, voffB); PG8_STAGE(PG8_SA(1, 0), a3, voffA);
            PG8_WAIT_V(8); PG8_WAIT_L(0); PG8_BAR; PG8_MMA(1, 0, At, B0); PG8_MMA(1, 1, At, B1); PG8_BAR; PG8_SCHED;
            } else {
            PG8_LDB(B0, 0, 0); PG8_SCHED; PG8_LDA(At, 0, 0); PG8_STAGE(PG8_SA(1, 1), a1 + hstep, voffA);
            PG8_WAIT_L(8); PG8_BAR; PG8_WAIT_L(0); PG8_MMA(0, 0, At, B0); PG8_BAR; PG8_SCHED;
            PG8_LDB(B1, 0, 1); PG8_STAGE(PG8_SB(0, 0), b2, voffB);
            PG8_BAR; PG8_WAIT_L(0); PG8_MMA(0, 1, At, B1); PG8_BAR;
            PG8_LDA(At, 0, 1); PG8_STAGE(PG8_SA(0, 0), a2, voffA);
            PG8_BAR; PG8_WAIT_L(0); PG8_MMA(1, 0, At, B0); PG8_BAR; PG8_SCHED;
            PG8_STAGE(PG8_SB(0, 1), b2 + hstep, voffB);
            PG8_WAIT_V(6); PG8_BAR; PG8_MMA(1, 1, At, B1); PG8_BAR;
            PG8_LDB(B0, 1, 0); PG8_SCHED; PG8_LDA(At, 1, 0); PG8_STAGE(PG8_SA(0, 1), a2 + hstep, voffA);
            PG8_WAIT_L(8); PG8_BAR; PG8_WAIT_L(0); PG8_MMA(0, 0, At, B0); PG8_BAR; PG8_SCHED;
            PG8_LDB(B1, 1, 1); PG8_STAGE(PG8_SB(1, 0), b3, voffB);
            PG8_BAR; PG8_WAIT_L(0); PG8_MMA(0, 1, At, B1); PG8_BAR;
            PG8_LDA(At, 1, 1); PG8_STAGE(PG8_SA(1, 0), a3, voffA);
            PG8_BAR; PG8_WAIT_L(0); PG8_MMA(1, 0, At, B0); PG8_BAR; PG8_SCHED;
            PG8_STAGE(PG8_SB(1, 1), b3 + hstep, voffB);
            PG8_WAIT_V(6); PG8_BAR; PG8_MMA(1, 1, At, B1); PG8_BAR;
            }
        }
        if constexpr (ALIGN_EPI) { if (wr == 0) PG8_BAR; }
        if constexpr (!Epi::AFTER_DRAIN) { E(acc, cur, wr, wc, fr, fq); S.done(cur); }
        if (!has_next) break;
#pragma unroll
        for (int a = 0; a < 2; ++a)
#pragma unroll
            for (int b = 0; b < 2; ++b)
#pragma unroll
                for (int m = 0; m < 4; ++m)
#pragma unroll
                    for (int n = 0; n < 2; ++n) acc[a][b][m][n] = (f32x4){0.f, 0.f, 0.f, 0.f};
        cur = nxt; cA = nA; cB = nB; ++ui; nt = cur.nt;
        if constexpr (ALIGN_EPI) { if (wr == 1) PG8_BAR; }
    }
    PG8_WAIT_V(0);
    if constexpr (!ALIGN_EPI) { if (wr == 0) PG8_BAR; }
    PG8_BAR;
    if constexpr (Epi::AFTER_DRAIN) { E.fused(acc, cur, wr, wc, fr, fq, lds, wid, lane); S.done(cur); }
#undef PG8_SA
#undef PG8_SB
#undef PG8_STAGE
#undef PG8_LDA
#undef PG8_LDB
#undef PG8_MMA
#undef PG8_WAIT_V
#undef PG8_WAIT_L
#undef PG8_BAR
#undef PG8_SCHED
}
}

constexpr int NWAVES = 8;
constexpr int D = 4096, TP = 8192, TS = 512, MROWS = TP + TS, DB = 128, DSQ = 4;
constexpr int NIN = 9232, NINP = 9472, F2 = 22016, FF = 11008, NMOD = 24576;
constexpr int PC_GQ = 0, PC_GK = 1024, PC_GV = 2048, PC_GR = 4096, PC_SQ = 6144, PC_SK = 8192, PC_SV = 8704, PC_GA = 9216;
constexpr float NORM_EPS = 1e-6f;
constexpr size_t MiB = 1u << 20;
constexpr size_t WS_CTL = 0, CTL_ZERO_BYTES = 65536;
constexpr size_t WS_CS = 1 * MiB;
constexpr size_t WS_MOD = 3 * MiB;
constexpr size_t WS_WIN = 27 * MiB;
constexpr size_t WS_WO = 101 * MiB;
constexpr size_t WS_WUP = 133 * MiB;
constexpr size_t WS_WDN = 305 * MiB;
constexpr size_t WS_X1 = 391 * MiB;
constexpr size_t WS_X2 = 459 * MiB;
constexpr size_t WS_H = 527 * MiB;
constexpr size_t WS_MIX = 595 * MiB;
constexpr size_t WS_BIG = 663 * MiB;
constexpr size_t WS_WADA = WS_BIG;
constexpr size_t WS_PROJ = 855 * MiB;
constexpr size_t WS_CHK = 1013 * MiB;
constexpr size_t WS_VTF = 1046 * MiB;
constexpr size_t WS_OIA = 1078 * MiB;
constexpr size_t WS_SPF = 1142 * MiB;
constexpr size_t WS_UE = WS_BIG;
constexpr size_t WS_US = 760 * MiB;
constexpr size_t WS_G = 1029 * MiB;
constexpr size_t WS_SLAB = 1212 * MiB;
constexpr size_t WS_END = 1276 * MiB;
static_assert(WS_UE + (size_t)2048 * F2 * 2 <= WS_US && WS_US + (size_t)TS * F2 * 2 <= WS_G && WS_G + (size_t)MROWS * FF * 2 <= WS_SLAB && WS_PROJ + (size_t)MROWS * NINP * 2 <= WS_CHK && WS_CHK + 512 * 66560 <= WS_VTF && WS_VTF + 32 * MiB <= WS_OIA && WS_WADA + (size_t)NMOD * D * 2 <= WS_PROJ, "ws map");
constexpr int CW_WORK = 64, CW_WORK4 = 128, CW_WORK5 = 192;
constexpr int CW_BAR = 4096;
constexpr size_t O_Y = 0, O_GLA_P = 35651584, O_K_P = 36175872, O_V_P = 36241408, O_CONV_P = 36306944, O_GLA_S = 36350976, O_K_S = 103459840, O_V_S = 111848448, O_CONV_S = 120237056, O_END = 125873152;
constexpr int LDS_BYTES = 147456, LDS_SCR = 1024;

#define GAS __attribute__((address_space(1)))
#define LAS __attribute__((address_space(3)))
#define DI __device__ __forceinline__
typedef unsigned short bf16;
typedef unsigned u32x4 __attribute__((ext_vector_type(4)));
typedef unsigned u32x2 __attribute__((ext_vector_type(2)));
typedef float f32x4 __attribute__((ext_vector_type(4)));
typedef short bf16x8 __attribute__((ext_vector_type(8)));
typedef short bf16x4 __attribute__((ext_vector_type(4)));
#define LDS_WAIT() asm volatile("s_waitcnt lgkmcnt(0)" ::: "memory")
#define VM_WAIT() asm volatile("s_waitcnt vmcnt(0)" ::: "memory")
#define MFMA16(a, b, c) __builtin_amdgcn_mfma_f32_16x16x32_bf16((a), (b), (c), 0, 0, 0)
DI int opq(int x) { asm volatile("" : "+v"(x)); return x; }
DI float bf2f(unsigned v) { return __uint_as_float(v << 16); }
DI float bflo(unsigned w) { return __uint_as_float(w << 16); }
DI float bfhi(unsigned w) { return __uint_as_float(w & 0xffff0000u); }
DI unsigned pkbf(float lo, float hi) { return pg8::cvt_pk_bf16(lo, hi); }
DI float wave_sum(float v) {
#pragma unroll
    for (int o = 1; o < 64; o <<= 1) v += __shfl_xor(v, o);
    return v;
}
DI float silu_f(float x) { return x / (1.0f + __expf(-x)); }
DI float logsig16(float z) { return (fminf(z, 0.0f) - __logf(1.0f + __expf(-fabsf(z)))) * 0.0625f; }
#define XB_TMO      128
#define XB_XCNT(j)  (256  + 64 * (j))
#define XB_XSUB(j)  (1280 + 64 * (j))
#define XB_XGEN(j)  (2304 + 64 * (j))
#define XB_TOP      3328
#define XB_TOPGEN   3392
#define XCD_BAR_WORDS 3456
#define XB_SPIN_CAP (1u << 18)

__device__ __forceinline__ unsigned xb_ld(unsigned* p)              { return __hip_atomic_load(p, __ATOMIC_RELAXED, __HIP_MEMORY_SCOPE_AGENT); }
__device__ __forceinline__ unsigned xb_add(unsigned* p, unsigned v) { return __hip_atomic_fetch_add(p, v, __ATOMIC_RELAXED, __HIP_MEMORY_SCOPE_AGENT); }
__device__ __forceinline__ unsigned xb_xcc_id() { return (unsigned)__builtin_amdgcn_s_getreg((3 << 11) | 20) & 0xFu; }
#define XB_SPIN(cond, bar) do { unsigned _sp = 0; while (cond) { __builtin_amdgcn_s_sleep(1); \
    if ((++_sp & 255u) == 0u) { if (xb_ld(&(bar)[XB_TMO])) break; if (_sp > XB_SPIN_CAP) { atomicAdd(&(bar)[XB_TMO], 1u); break; } } } } while (0)

struct XcdBarrier {
    unsigned* bar; unsigned x;
    volatile LAS unsigned* st;
};

__device__ __forceinline__ XcdBarrier xcd_barrier_post(unsigned* bar, volatile LAS unsigned* st) {
    XcdBarrier b; b.bar = bar; b.x = xb_xcc_id(); b.st = st;
    if (threadIdx.x == 0) (void)xb_add(&bar[XB_XCNT(b.x)], 1u);
    return b;
}
__device__ __forceinline__ void xcd_barrier_complete(unsigned* bar, unsigned x, unsigned& nloc, unsigned& nx) {
    const unsigned G = gridDim.x * gridDim.y * gridDim.z;
    unsigned sum, cnt, mine, sp = 0u;
    for (;;) {
        sum = 0u; cnt = 0u; mine = 0u;
#pragma unroll
        for (unsigned j = 0; j < 16; ++j) { const unsigned c = xb_ld(&bar[XB_XCNT(j)]); sum += c; cnt += (c > 0u) ? 1u : 0u; mine = (j == x) ? c : mine; }
        if (sum == G) break;
        __builtin_amdgcn_s_sleep(1);
        if ((++sp & 255u) == 0u) { if (xb_ld(&bar[XB_TMO])) break; if (sp > XB_SPIN_CAP) { atomicAdd(&bar[XB_TMO], 1u); break; } }
    }
    nloc = mine > 0u ? mine : 1u; nx = cnt > 0u ? cnt : 1u;
}

__device__ __forceinline__ void xcd_barrier(const XcdBarrier& b) {
    asm volatile("s_waitcnt vmcnt(0)" ::: "memory");
    __syncthreads();
    if (threadIdx.x == 0) {
        unsigned* bar = b.bar;
        __builtin_amdgcn_s_waitcnt(0);
        unsigned nloc = b.st[0], nx = b.st[1];
        if (nloc == 0u) { xcd_barrier_complete(bar, b.x, nloc, nx); b.st[0] = nloc; b.st[1] = nx; }
        const unsigned old = xb_add(&bar[XB_XSUB(b.x)], 1u);
        const unsigned gen = old / nloc;
        if (old + 1u == (gen + 1u) * nloc) {
            __builtin_amdgcn_fence(__ATOMIC_RELEASE, "agent");
            asm volatile("s_waitcnt vmcnt(0)" ::: "memory");
            const unsigned og = xb_add(&bar[XB_TOP], 1u);
            const unsigned tg = og / nx;
            if (og + 1u == (tg + 1u) * nx) xb_add(&bar[XB_TOPGEN], 1u);
            else XB_SPIN(xb_ld(&bar[XB_TOPGEN]) == tg, bar);
            __builtin_amdgcn_fence(__ATOMIC_ACQUIRE, "agent");
            xb_add(&bar[XB_XGEN(b.x)], 1u);
            asm volatile("s_waitcnt vmcnt(0)" ::: "memory");
        } else {
            XB_SPIN(xb_ld(&bar[XB_XGEN(b.x)]) == gen, bar);
            __builtin_amdgcn_fence(__ATOMIC_ACQUIRE, "agent");
            asm volatile("s_waitcnt vmcnt(0)" ::: "memory");
        }
    }
    __syncthreads();
}

struct Args { const float* in[22]; float* out; unsigned char* ws; int ph_lo, ph_hi, li, pad; };
enum { I_XP = 0, I_XS, I_CP, I_CS, I_SGLA, I_SK, I_SV, I_SCONV, I_WADA, I_BADA, I_GNORM, I_WIN, I_WAUP, I_BA, I_GGLA, I_SINK, I_WO, I_WUP, I_WCONV, I_BCONV, I_WDN, I_GFIN };

DI size_t wt_off(int nrow, int K, int k) {
    const int nl = nrow & 127, c = nl & 31, rho = 16 * ((c >> 2) & 1) + 4 * (c >> 3) + (c & 3);
    return ((size_t)(nrow >> 7) * (K >> 6) + (k >> 6)) * 16384 + pg8::lds_byte((nl & ~31) + rho, k & 63);
}
DI void tr_item(const float* __restrict__ W, int ldw, int k0, int nsrc0, int nvalid, bf16* __restrict__ WT, int ldt, int ndst0, LAS unsigned char* scr, int lane) {
    const int rg = lane >> 4, c4 = lane & 15;
    f32x4 v[4][4];
    const bool ok = (4 * c4) < nvalid;
#pragma unroll
    for (int kq = 0; kq < 4; ++kq)
#pragma unroll
        for (int j = 0; j < 4; ++j) {
            if (ok) v[kq][j] = *(const f32x4*)(W + (size_t)(k0 + 16 * kq + 4 * rg + j) * ldw + nsrc0 + 4 * c4);
            else v[kq][j] = (f32x4){0.f, 0.f, 0.f, 0.f};
        }
    const int x = 2 * (c4 & 7);
#pragma unroll
    for (int kq = 0; kq < 4; ++kq)
#pragma unroll
        for (int jn = 0; jn < 4; ++jn) {
            u32x2 w; w.x = pkbf(v[kq][0][jn], v[kq][1][jn]); w.y = pkbf(v[kq][2][jn], v[kq][3][jn]);
            const int g = 4 * kq + rg, n = 4 * c4 + jn;
            *(LAS u32x2*)(scr + n * 128 + ((g ^ x) * 8)) = w;
        }
    LDS_WAIT();
#pragma unroll
    for (int i = 0; i < 8; ++i) {
        const int n = (lane >> 3) + 8 * i, kc = lane & 7, xx = 2 * ((n >> 2) & 7);
        const u32x4 w = *(const LAS u32x4*)(scr + n * 128 + (((2 * kc) ^ xx) * 8));
        *(u32x4*)((unsigned char*)WT + wt_off(ndst0 + n, ldt, k0 + 8 * kc)) = w;
    }
    LDS_WAIT();
}
DI void tr_load(f32x4 (&v)[4][4], const float* __restrict__ W, int ldw, int k0, int nsrc0, int lane) {
    const int rg = lane >> 4, c4 = lane & 15;
#pragma unroll
    for (int kq = 0; kq < 4; ++kq)
#pragma unroll
        for (int j = 0; j < 4; ++j) v[kq][j] = *(const f32x4*)(W + (size_t)(k0 + 16 * kq + 4 * rg + j) * ldw + nsrc0 + 4 * c4);
}
DI void tr_emit(const f32x4 (&v)[4][4], bf16* __restrict__ WT, int ldt, int k0, int ndst0, LAS unsigned char* scr, int lane) {
    const int rg = lane >> 4, c4 = lane & 15, x = 2 * (c4 & 7);
#pragma unroll
    for (int kq = 0; kq < 4; ++kq)
#pragma unroll
        for (int jn = 0; jn < 4; ++jn) {
            u32x2 w; w.x = pkbf(v[kq][0][jn], v[kq][1][jn]); w.y = pkbf(v[kq][2][jn], v[kq][3][jn]);
            const int g = 4 * kq + rg, n = 4 * c4 + jn;
            *(LAS u32x2*)(scr + n * 128 + ((g ^ x) * 8)) = w;
        }
    LDS_WAIT();
#pragma unroll
    for (int i = 0; i < 8; ++i) {
        const int n = (lane >> 3) + 8 * i, kc = lane & 7, xx = 2 * ((n >> 2) & 7);
        const u32x4 w = *(const LAS u32x4*)(scr + n * 128 + (((2 * kc) ^ xx) * 8));
        *(u32x4*)((unsigned char*)WT + wt_off(ndst0 + n, ldt, k0 + 8 * kc)) = w;
    }
    LDS_WAIT();
}
DI void tr_plain2(const float* W, int K, int N, bf16* WT, int itA, int itB, LAS unsigned char* scr, int lane) {
    const int nb = N / 64, kA = itA / nb, nA = itA % nb, kB = itB / nb, nB = itB % nb;
    f32x4 va[4][4], vb[4][4];
    tr_load(va, W, N, 64 * kA, 64 * nA, lane); tr_load(vb, W, N, 64 * kB, 64 * nB, lane);
    tr_emit(va, WT, K, 64 * kA, 64 * nA, scr, lane); tr_emit(vb, WT, K, 64 * kB, 64 * nB, scr, lane);
}
DI void tr_wup2(const float* W, bf16* WT, int itA, int itB, LAS unsigned char* scr, int lane) {
    constexpr int nb = F2 / 64;
    const int kA = itA / nb, dA = itA % nb, kB = itB / nb, dB = itB % nb;
    const int sA = 64 * ((dA & 2) ? FF / 64 + 2 * (dA >> 2) + (dA & 1) : 2 * (dA >> 2) + (dA & 1)), sB = 64 * ((dB & 2) ? FF / 64 + 2 * (dB >> 2) + (dB & 1) : 2 * (dB >> 2) + (dB & 1));
    f32x4 va[4][4], vb[4][4];
    tr_load(va, W, F2, 64 * kA, sA, lane); tr_load(vb, W, F2, 64 * kB, sB, lane);
    tr_emit(va, WT, D, 64 * kA, 64 * dA, scr, lane); tr_emit(vb, WT, D, 64 * kB, 64 * dB, scr, lane);
}
DI void tr_plain(const float* W, int K, int N, bf16* WT, int it, LAS unsigned char* scr, int lane) {
    const int nb = N / 64, kb = it / nb, n = it % nb;
    tr_item(W, N, 64 * kb, 64 * n, 64, WT, K, 64 * n, scr, lane);
}
DI void tr_win(const float* W, bf16* WT, int it, LAS unsigned char* scr, int lane) {
    constexpr int nb = NINP / 64;
    const int kb = it / nb, n = it % nb;
    int nsrc0, nvalid;
    if (n < 96) { nsrc0 = 64 * n; nvalid = 64; }
    else if (n < 144) { nsrc0 = 64 * n + 16; nvalid = 64; }
    else if (n == 144) { nsrc0 = 6144; nvalid = 16; }
    else { nsrc0 = 0; nvalid = 0; }
    tr_item(W, NIN, 64 * kb, nsrc0, nvalid, WT, D, 64 * n, scr, lane);
}

constexpr int AD_CS_PITCH = 144, AD_CS_BYTES = 144 * AD_CS_PITCH, AD_IMG = 2 * AD_CS_BYTES, AD_IMG_PITCH = 144, AD_IMG_BYTES = 16 * AD_IMG_PITCH;
DI void adaln_block(int item0, const float* c_sample, const float* c_prompt, const float* W, const float* bias, float* MOD, LAS unsigned char* scr, int tid) {
    const int wave = tid >> 6, lane = tid & 63, l15 = lane & 15, quad = lane >> 4;
    const int n0 = 16 * (item0 + wave);
    LAS unsigned char* img = scr + AD_IMG + wave * AD_IMG_BYTES;
    for (int i = tid; i < 2 * 15 * (AD_CS_PITCH / 16); i += 512) { const int b = i / (15 * (AD_CS_PITCH / 16)), j = i % (15 * (AD_CS_PITCH / 16));
        *(LAS u32x4*)(scr + b * AD_CS_BYTES + 129 * AD_CS_PITCH + j * 16) = (u32x4){0u, 0u, 0u, 0u}; }
    f32x4 acc[9];
#pragma unroll
    for (int m = 0; m < 9; ++m) acc[m] = (f32x4){0.f, 0.f, 0.f, 0.f};
    const int rg = lane >> 2, c4 = lane & 3;
    const float* wp = W + (size_t)(4 * rg) * NMOD + n0 + 4 * c4;
    f32x4 wa[4], wb[4];
#pragma unroll
    for (int j = 0; j < 4; ++j) { wa[j] = __builtin_nontemporal_load((const f32x4*)(wp + (size_t)j * NMOD)); wb[j] = __builtin_nontemporal_load((const f32x4*)(wp + (size_t)(64 + j) * NMOD)); }
    f32x4 cv[5];
#define AD_CLOAD(s) do { _Pragma("unroll") for (int t = 0; t < 5; ++t) { int i = tid + 512 * t; i = i < 129 * 16 ? i : 129 * 16 - 1; const int m = i >> 4, q = i & 15; \
        cv[t] = *(const f32x4*)((m < 128 ? c_sample + (size_t)m * D : c_prompt) + 64 * (s) + 4 * q); } } while (0)
#define AD_CSTORE(buf) do { _Pragma("unroll") for (int t = 0; t < 5; ++t) { const int i = tid + 512 * t; const int m = i >> 4, q = i & 15; \
        u32x2 w; w.x = pkbf(silu_f(cv[t].x), silu_f(cv[t].y)); w.y = pkbf(silu_f(cv[t].z), silu_f(cv[t].w)); \
        if (i < 129 * 16) *(LAS u32x2*)((buf) + m * AD_CS_PITCH + q * 8) = w; } } while (0)
    AD_CLOAD(0); AD_CSTORE(scr);
    __syncthreads();
#define AD_STEP(wc, kblk) do { \
        const LAS unsigned char* abuf = scr + ((kblk) & 1) * AD_CS_BYTES; \
        { const int sn = (kblk) + 1 < 64 ? (kblk) + 1 : 63; AD_CLOAD(sn); }     \
        _Pragma("unroll") for (int jn = 0; jn < 4; ++jn) { u32x2 w; w.x = pkbf(wc[0][jn], wc[1][jn]); w.y = pkbf(wc[2][jn], wc[3][jn]); *(LAS u32x2*)(img + (4 * c4 + jn) * AD_IMG_PITCH + rg * 8) = w; } \
        { const int kn = (kblk) + 2 < 64 ? (kblk) + 2 : 63;                    \
          _Pragma("unroll") for (int j = 0; j < 4; ++j) wc[j] = __builtin_nontemporal_load((const f32x4*)(wp + (size_t)(64 * kn + j) * NMOD)); } \
        bf16x8 af[18];                                                         \
        _Pragma("unroll") for (int m = 0; m < 9; ++m) { const LAS unsigned char* ap = abuf + (16 * m + l15) * AD_CS_PITCH + (8 * quad) * 2; af[2 * m] = *(const LAS bf16x8*)ap; af[2 * m + 1] = *(const LAS bf16x8*)(ap + 64); } \
        const bf16x8 b0 = *(const LAS bf16x8*)(img + l15 * AD_IMG_PITCH + (8 * quad) * 2), b1 = *(const LAS bf16x8*)(img + l15 * AD_IMG_PITCH + (32 + 8 * quad) * 2); \
        __builtin_amdgcn_sched_barrier(0); \
        _Pragma("unroll") for (int m = 0; m < 9; ++m) acc[m] = MFMA16(af[2 * m], b0, acc[m]); \
        _Pragma("unroll") for (int m = 0; m < 9; ++m) acc[m] = MFMA16(af[2 * m + 1], b1, acc[m]); \
        __builtin_amdgcn_sched_barrier(0); \
        AD_CSTORE(scr + (((kblk) + 1) & 1) * AD_CS_BYTES);                     \
        __syncthreads(); } while (0)
#pragma unroll 1
    for (int kb2 = 0; kb2 < 64; kb2 += 2) { AD_STEP(wa, kb2); AD_STEP(wb, kb2 + 1); }
#undef AD_STEP
#undef AD_CLOAD
#undef AD_CSTORE
    const float bv = bias[n0 + l15];
#pragma unroll
    for (int m = 0; m < 9; ++m)
#pragma unroll
        for (int r = 0; r < 4; ++r) { const int row = 16 * m + 4 * quad + r; if (row <= 128) MOD[(size_t)row * NMOD + n0 + l15] = acc[m][r] + bv; }
    __syncthreads();
}

DI f32x4 ld4(const float* p) { return *(const f32x4*)p; }
DI f32x4 ld4(const bf16* p) { const u32x2 w = *(const u32x2*)p; return (f32x4){bflo(w.x), bfhi(w.x), bflo(w.y), bfhi(w.y)}; }
template <class T> DI void slab_reduce_row(const T* base, const float* gate, const float* slab_row, bf16* xout, int lane) {
#pragma unroll 1
    for (int j = 0; j < 16; ++j) {
        const int c = 4 * (lane + 64 * j);
        f32x4 s = *(const f32x4*)(slab_row + c);
#pragma unroll
        for (int ks = 1; ks < 8; ++ks) s += *(const f32x4*)(slab_row + (size_t)ks * 512 * 4096 + c);
        const f32x4 v = ld4(base + c) + *(const f32x4*)(gate + c) * s;
        u32x2 w; w.x = pkbf(v.x, v.y); w.y = pkbf(v.z, v.w);
        *(u32x2*)(xout + c) = w;
    }
}
DI void modnorm_row(const float* xrow, const float* g, const float* sc, const float* sh, bf16* orow, int lane) {
    f32x4 v[16]; float s = 0.f;
#pragma unroll
    for (int j = 0; j < 16; ++j) { v[j] = *(const f32x4*)(xrow + 4 * (lane + 64 * j)); s += (v[j].x * v[j].x + v[j].y * v[j].y) + (v[j].z * v[j].z + v[j].w * v[j].w); }
    const float rstd = 1.0f / sqrtf(wave_sum(s) * (1.0f / D) + NORM_EPS);
#pragma unroll
    for (int j = 0; j < 16; ++j) {
        const int c = 4 * (lane + 64 * j);
        const f32x4 gv = *(const f32x4*)(g + c), sv = *(const f32x4*)(sc + c), hv = *(const f32x4*)(sh + c);
        const f32x4 o = (v[j] * rstd) * gv * (sv + 1.0f) + hv;
        u32x2 w; w.x = pkbf(o.x, o.y); w.y = pkbf(o.z, o.w);
        *(u32x2*)(orow + c) = w;
    }
}
DI void load_row_bf(f32x4 (&v)[16], const bf16* xrow, int lane) {
#pragma unroll
    for (int j = 0; j < 8; ++j) { const u32x4 w = *(const u32x4*)(xrow + 8 * (lane + 64 * j));
        v[2 * j] = (f32x4){bflo(w.x), bfhi(w.x), bflo(w.y), bfhi(w.y)}; v[2 * j + 1] = (f32x4){bflo(w.z), bfhi(w.z), bflo(w.w), bfhi(w.w)}; }
}
DI void modnorm_row(const bf16* xrow, const float* g, const float* sc, const float* sh, bf16* orow, int lane) {
    f32x4 v[16]; float s = 0.f;
    load_row_bf(v, xrow, lane);
#pragma unroll
    for (int j = 0; j < 16; ++j) s += (v[j].x * v[j].x + v[j].y * v[j].y) + (v[j].z * v[j].z + v[j].w * v[j].w);
    const float rstd = 1.0f / sqrtf(wave_sum(s) * (1.0f / D) + NORM_EPS);
#pragma unroll
    for (int j = 0; j < 8; ++j) {
        const int c = 8 * (lane + 64 * j);
        u32x4 w; unsigned* wp = (unsigned*)&w;
#pragma unroll
        for (int hh = 0; hh < 2; ++hh) {
            const f32x4 gv = *(const f32x4*)(g + c + 4 * hh), sv = *(const f32x4*)(sc + c + 4 * hh), hv = *(const f32x4*)(sh + c + 4 * hh);
            const f32x4 o = (v[2 * j + hh] * rstd) * gv * (sv + 1.0f) + hv;
            wp[2 * hh] = pkbf(o.x, o.y); wp[2 * hh + 1] = pkbf(o.z, o.w);
        }
        *(u32x4*)(orow + c) = w;
    }
}
DI void finalnorm_row(const bf16* xrow, float* orow, const float* g, int lane) {
    f32x4 v[16]; float s = 0.f;
    load_row_bf(v, xrow, lane);
#pragma unroll
    for (int j = 0; j < 16; ++j) s += (v[j].x * v[j].x + v[j].y * v[j].y) + (v[j].z * v[j].z + v[j].w * v[j].w);
    const float rstd = 1.0f / sqrtf(wave_sum(s) * (1.0f / D) + NORM_EPS);
#pragma unroll
    for (int j = 0; j < 8; ++j) { const int c = 8 * (lane + 64 * j);
        *(f32x4*)(orow + c) = (v[2 * j] * rstd) * *(const f32x4*)(g + c); *(f32x4*)(orow + c + 4) = (v[2 * j + 1] * rstd) * *(const f32x4*)(g + c + 4); }
}

constexpr int KS_PITCH = 272, VT_PITCH = 528, SWA_KS_OFF = 0, SWA_VT_OFF = 256 * KS_PITCH;
template <int NDM>
DI void swa_group(const LAS unsigned char* Ks, const LAS unsigned char* Vt, const bf16* qptr, int ts, int ie, int kmin, float slope, float sink, int dbase, bf16* optr, int lane) {
    const int l15 = lane & 15, quad = lane >> 4;
    bf16x8 bq[4];
#pragma unroll
    for (int s = 0; s < 4; ++s) bq[s] = *(const bf16x8*)(qptr + 32 * s + 8 * quad);
    f32x4 sc[10];
#pragma unroll
    for (int kt = 0; kt < 10; ++kt) sc[kt] = (f32x4){0.f, 0.f, 0.f, 0.f};
#define SW_SB() __builtin_amdgcn_sched_barrier(0)
#define SW_LK(f, p) do { _Pragma("unroll") for (int i = 0; i < 8; ++i) f[i] = *(const LAS bf16x8*)(Ks + (16 * (ts + 2 * (p) + (i >> 2)) + l15) * KS_PITCH + (32 * (i & 3) + 8 * quad) * 2); } while (0)
#define SW_MK(f, p) do { _Pragma("unroll") for (int i = 0; i < 8; ++i) sc[2 * (p) + (i >> 2)] = MFMA16(f[i], bq[i & 3], sc[2 * (p) + (i >> 2)]); } while (0)
    {
        bf16x8 ka[8], kb[8];
        SW_LK(ka, 0); SW_LK(kb, 1);
        SW_SB(); SW_MK(ka, 0); SW_SB(); SW_LK(ka, 2);
        SW_SB(); SW_MK(kb, 1); SW_SB(); SW_LK(kb, 3);
        SW_SB(); SW_MK(ka, 2); SW_SB(); SW_LK(ka, 4);
        SW_SB(); SW_MK(kb, 3);
        SW_SB(); SW_MK(ka, 4); SW_SB();
    }
    float mx = sink;
#pragma unroll
    for (int kt = 0; kt < 10; ++kt)
#pragma unroll
        for (int r = 0; r < 4; ++r) {
            const int key = 16 * (ts + kt) + 4 * quad + r, dd = 128 + ie - key;
            const bool valid = (dd >= 0) && (dd <= 128) && (key >= kmin);
            const float sv = valid ? (sc[kt][r] * 0.08838834764831845f - slope * (float)dd) : -1e30f;
            sc[kt][r] = sv; mx = fmaxf(mx, sv);
        }
    mx = fmaxf(mx, __shfl_xor(mx, 16)); mx = fmaxf(mx, __shfl_xor(mx, 32));
    float sum = 0.f;
#pragma unroll
    for (int kt = 0; kt < 10; ++kt)
#pragma unroll
        for (int r = 0; r < 4; ++r) { const float p = __expf(sc[kt][r] - mx); sc[kt][r] = p; sum += p; }
    sum += __shfl_xor(sum, 16); sum += __shfl_xor(sum, 32);
    sum += __expf(sink - mx);
    const float inv = 1.0f / sum;
    f32x4 o[NDM];
#pragma unroll
    for (int dm = 0; dm < NDM; ++dm) o[dm] = (f32x4){0.f, 0.f, 0.f, 0.f};
#define SW_LV(f, st) do { _Pragma("unroll") for (int dm = 0; dm < NDM; ++dm) { const LAS unsigned char* vp = Vt + (dbase + 16 * dm + l15) * VT_PITCH + (16 * (ts + 2 * (st)) + 4 * quad) * 2; \
        const bf16x4 lo = *(const LAS bf16x4*)vp, hi = *(const LAS bf16x4*)(vp + 32); f[dm] = __builtin_shufflevector(lo, hi, 0, 1, 2, 3, 4, 5, 6, 7); } } while (0)
#define SW_MV(f, st) do { u32x4 pw; pw.x = pkbf(sc[2 * (st)][0], sc[2 * (st)][1]); pw.y = pkbf(sc[2 * (st)][2], sc[2 * (st)][3]); pw.z = pkbf(sc[2 * (st) + 1][0], sc[2 * (st) + 1][1]); pw.w = pkbf(sc[2 * (st) + 1][2], sc[2 * (st) + 1][3]); \
        const bf16x8 bp = __builtin_bit_cast(bf16x8, pw); _Pragma("unroll") for (int dm = 0; dm < NDM; ++dm) o[dm] = MFMA16(f[dm], bp, o[dm]); } while (0)
    {
        bf16x8 va[NDM], vb[NDM];
        SW_LV(va, 0); SW_LV(vb, 1);
        SW_SB(); SW_MV(va, 0); SW_SB(); SW_LV(va, 2);
        SW_SB(); SW_MV(vb, 1); SW_SB(); SW_LV(vb, 3);
        SW_SB(); SW_MV(va, 2); SW_SB(); SW_LV(va, 4);
        SW_SB(); SW_MV(vb, 3);
        SW_SB(); SW_MV(va, 4); SW_SB();
    }
#undef SW_SB
#undef SW_LK
#undef SW_MK
#undef SW_LV
#undef SW_MV
#pragma unroll
    for (int dm = 0; dm < NDM; ++dm) {
        u32x2 w; w.x = pkbf(o[dm][0] * inv, o[dm][1] * inv); w.y = pkbf(o[dm][2] * inv, o[dm][3] * inv);
        *(u32x2*)(optr + 16 * dm + 4 * quad) = w;
    }
}
DI float alibi_slope(int head) { return exp2f(-0.5f * (float)(head + 1)); }
DI f32x4 bf4lo(const u32x4 w) { return (f32x4){bflo(w.x), bfhi(w.x), bflo(w.y), bfhi(w.y)}; }
DI f32x4 bf4hi(const u32x4 w) { return (f32x4){bflo(w.z), bfhi(w.z), bflo(w.w), bfhi(w.w)}; }
DI void vt_store(LAS unsigned char* Vt, int c, int j0, const u32x4 w0, const u32x4 w1) {
    LAS unsigned char* vb = Vt + (8 * c) * VT_PITCH + j0 * 2;
    *(LAS unsigned*)(vb + 0 * VT_PITCH) = (w0.x & 0xffffu) | (w1.x << 16);
    *(LAS unsigned*)(vb + 1 * VT_PITCH) = (w0.x >> 16) | (w1.x & 0xffff0000u);
    *(LAS unsigned*)(vb + 2 * VT_PITCH) = (w0.y & 0xffffu) | (w1.y << 16);
    *(LAS unsigned*)(vb + 3 * VT_PITCH) = (w0.y >> 16) | (w1.y & 0xffff0000u);
    *(LAS unsigned*)(vb + 4 * VT_PITCH) = (w0.z & 0xffffu) | (w1.z << 16);
    *(LAS unsigned*)(vb + 5 * VT_PITCH) = (w0.z >> 16) | (w1.z & 0xffff0000u);
    *(LAS unsigned*)(vb + 6 * VT_PITCH) = (w0.w & 0xffffu) | (w1.w << 16);
    *(LAS unsigned*)(vb + 7 * VT_PITCH) = (w0.w >> 16) | (w1.w & 0xffff0000u);
}

DI void swa_prompt_unit(int qb, int kvh, const bf16* PROJ, const float* sinks, bf16* MIX, float* outK, float* outV, LAS unsigned char* scr, int tid) {
    LAS unsigned char* Ks = scr + SWA_KS_OFF; LAS unsigned char* Vt = scr + SWA_VT_OFF;
    const int pos_base = 128 * (qb - 1);
    {
        u32x4 kw[8];
#pragma unroll
        for (int it = 0; it < 8; ++it) {
            const int ch = tid + 512 * it, j = ch >> 4, c = ch & 15, pos = pos_base + j;
            kw[it] = (u32x4){0u, 0u, 0u, 0u};
            if (pos >= 0) kw[it] = *(const u32x4*)(PROJ + (size_t)pos * NINP + PC_SK + kvh * 128 + 8 * c);
        }
#pragma unroll
        for (int it = 0; it < 8; ++it) { const int ch = tid + 512 * it; *(LAS u32x4*)(Ks + (ch >> 4) * KS_PITCH + (ch & 15) * 16) = kw[it]; }
    }
    {
        u32x4 vw[8];
#pragma unroll
        for (int it = 0; it < 4; ++it) {
            const int jp = tid & 127, c = (tid >> 7) + 4 * it, pos0 = pos_base + 2 * jp;
            vw[2 * it] = (u32x4){0u, 0u, 0u, 0u}; vw[2 * it + 1] = vw[2 * it];
            if (pos0 >= 0) { const bf16* p = PROJ + (size_t)pos0 * NINP + PC_SV + kvh * 128 + 8 * c; vw[2 * it] = *(const u32x4*)p; vw[2 * it + 1] = *(const u32x4*)(p + NINP); }
        }
#pragma unroll
        for (int it = 0; it < 4; ++it) vt_store(Vt, (tid >> 7) + 4 * it, 2 * (tid & 127), vw[2 * it], vw[2 * it + 1]);
    }
    if (qb == 63) {
#pragma unroll 1
        for (int ch = tid; ch < 2 * 128 * 16; ch += 512) {
            const int kv = ch >> 11, j = (ch >> 4) & 127, c = ch & 15;
            const u32x4 w = *(const u32x4*)(PROJ + (size_t)(TP - 128 + j) * NINP + (kv ? PC_SV : PC_SK) + kvh * 128 + 8 * c);
            float* o = (kv ? outV : outK) + (size_t)j * 512 + kvh * 128 + 8 * c; *(f32x4*)o = bf4lo(w); *(f32x4*)(o + 4) = bf4hi(w);
        }
    }
    __syncthreads();
    const int wave = tid >> 6, lane = tid & 63, l15 = lane & 15;
    const int g = wave >> 1, head = kvh * 4 + g;
    const float slope = alibi_slope(head), sink = sinks[head];
#pragma unroll 1
    for (int q4 = 0; q4 < 4; ++q4) {
        const int i0 = 64 * (wave & 1) + 16 * q4, ts = (i0 >> 4) < 6 ? (i0 >> 4) : 6;
        const size_t row = (size_t)128 * qb + i0 + l15;
        swa_group<8>(Ks, Vt, PROJ + row * NINP + PC_SQ + head * 128, ts, i0 + l15, qb == 0 ? 128 : 0, slope, sink, 0, MIX + row * D + 2048 + head * 128, lane);
    }
    __syncthreads();
}
DI void swa_sample_unit(int b, int kvh, const bf16* PROJ, const float* stK, const float* stV, const float* sinks, bf16* MIX, float* outK, float* outV, LAS unsigned char* scr, int tid) {
    LAS unsigned char* Ks = scr + SWA_KS_OFF; LAS unsigned char* Vt = scr + SWA_VT_OFF;
    const size_t sbase = (size_t)b * 128 * 512 + kvh * 128;
    const size_t prow = (size_t)(TP + 4 * b);
    {
        f32x4 ka[4], kb[4];
#pragma unroll
        for (int it = 0; it < 4; ++it) { const int ch = tid + 512 * it; const float* p = stK + sbase + (size_t)(ch >> 4) * 512 + 8 * (ch & 15); ka[it] = __builtin_nontemporal_load((const f32x4*)p); kb[it] = __builtin_nontemporal_load((const f32x4*)(p + 4)); }
        f32x4 va[2][4];
#pragma unroll
        for (int it = 0; it < 2; ++it) { const int jp = tid & 63, c = (tid >> 6) + 8 * it; const float* p = stV + sbase + (size_t)(2 * jp) * 512 + 8 * c;
            va[it][0] = __builtin_nontemporal_load((const f32x4*)p); va[it][1] = __builtin_nontemporal_load((const f32x4*)(p + 4)); va[it][2] = __builtin_nontemporal_load((const f32x4*)(p + 512)); va[it][3] = __builtin_nontemporal_load((const f32x4*)(p + 516)); }
#pragma unroll
        for (int it = 0; it < 4; ++it) {
            const int ch = tid + 512 * it, j = ch >> 4, c = ch & 15;
            u32x4 w; w.x = pkbf(ka[it].x, ka[it].y); w.y = pkbf(ka[it].z, ka[it].w); w.z = pkbf(kb[it].x, kb[it].y); w.w = pkbf(kb[it].z, kb[it].w);
            *(LAS u32x4*)(Ks + j * KS_PITCH + c * 16) = w;
            if (j >= 4) { float* o = outK + sbase + (size_t)(j - 4) * 512 + 8 * c; *(f32x4*)o = ka[it]; *(f32x4*)(o + 4) = kb[it]; }
        }
#pragma unroll
        for (int it = 0; it < 2; ++it) {
            const int jp = tid & 63, c = (tid >> 6) + 8 * it, j0 = 2 * jp;
            u32x4 w0, w1;
            w0.x = pkbf(va[it][0].x, va[it][0].y); w0.y = pkbf(va[it][0].z, va[it][0].w); w0.z = pkbf(va[it][1].x, va[it][1].y); w0.w = pkbf(va[it][1].z, va[it][1].w);
            w1.x = pkbf(va[it][2].x, va[it][2].y); w1.y = pkbf(va[it][2].z, va[it][2].w); w1.z = pkbf(va[it][3].x, va[it][3].y); w1.w = pkbf(va[it][3].z, va[it][3].w);
            vt_store(Vt, c, j0, w0, w1);
            if (j0 >= 4) { float* o = outV + sbase + (size_t)(j0 - 4) * 512 + 8 * c; *(f32x4*)o = va[it][0]; *(f32x4*)(o + 4) = va[it][1]; *(f32x4*)(o + 512) = va[it][2]; *(f32x4*)(o + 516) = va[it][3]; }
        }
    }
    {
        const int j = 128 + (tid >> 4), c = tid & 15;
        u32x4 w = (u32x4){0u, 0u, 0u, 0u};
        if (j < 132) {
            w = *(const u32x4*)(PROJ + (prow + (j - 128)) * NINP + PC_SK + kvh * 128 + 8 * c);
            float* o = outK + sbase + (size_t)(j - 4) * 512 + 8 * c; *(f32x4*)o = bf4lo(w); *(f32x4*)(o + 4) = bf4hi(w);
        }
        *(LAS u32x4*)(Ks + j * KS_PITCH + c * 16) = w;
        if (tid < 256) {
            const int jp = 64 + (tid & 15), cv = tid >> 4, j0 = 2 * jp;
            u32x4 w0 = (u32x4){0u, 0u, 0u, 0u}, w1 = w0;
            if (j0 < 132) {
                const bf16* p = PROJ + (prow + (j0 - 128)) * NINP + PC_SV + kvh * 128 + 8 * cv; w0 = *(const u32x4*)p; w1 = *(const u32x4*)(p + NINP);
                float* o = outV + sbase + (size_t)(j0 - 4) * 512 + 8 * cv;
                *(f32x4*)o = bf4lo(w0); *(f32x4*)(o + 4) = bf4hi(w0); *(f32x4*)(o + 512) = bf4lo(w1); *(f32x4*)(o + 516) = bf4hi(w1);
            }
            vt_store(Vt, cv, j0, w0, w1);
        }
    }
    __syncthreads();
    const int wave = tid >> 6, lane = tid & 63, l15 = lane & 15;
    const int g = l15 >> 2, t = l15 & 3, head = kvh * 4 + g;
    const size_t row = prow + t;
    swa_group<1>(Ks, Vt, PROJ + row * NINP + PC_SQ + head * 128, 0, t, 0, alibi_slope(head), sinks[head], 16 * wave, MIX + row * D + 2048 + head * 128 + 16 * wave, lane);
    __syncthreads();
}

constexpr int CHK_BYTES = 66560;
constexpr int GL_GA = 0, GL_PART = 4096, GL_QG = 6144, GL_KG = 6144 + 33792, GL_VTF = 6144 + 2 * 33792, GL_AM = GL_QG, GL_PITCH = 528, AM_PITCH = 144;
DI void gla_local_unit(int n, int h, const bf16* PROJ, const float* w_a_up, const float* b_a, unsigned char* CHK, unsigned char* VTF, bf16* OIA, LAS unsigned char* scr, int tid, int stop) {
    const size_t row0 = (size_t)64 * n, hn = (size_t)h * 128 + n;
    const int wave = tid >> 6, lane = tid & 63, l15 = lane & 15, quad = lane >> 4;
    LAS float* gaS = (LAS float*)(scr + GL_GA); LAS float* partS = (LAS float*)(scr + GL_PART);
    LAS float* ZS = (LAS float*)(scr + GL_VTF);
    for (int idx = tid; idx < 1024; idx += 512) gaS[idx] = bf2f(PROJ[(row0 + (idx >> 4)) * NINP + PC_GA + (idx & 15)]);
    u32x4 wv[8];
    {
        const bf16* vp = PROJ + row0 * NINP + PC_GV + h * 512 + tid;
#pragma unroll
        for (int g8 = 0; g8 < 8; ++g8) {
            unsigned e[8];
#pragma unroll
            for (int j = 0; j < 8; ++j) e[j] = vp[(size_t)(8 * g8 + j) * NINP];
            wv[g8].x = e[0] | (e[1] << 16); wv[g8].y = e[2] | (e[3] << 16); wv[g8].z = e[4] | (e[5] << 16); wv[g8].w = e[6] | (e[7] << 16);
        }
    }
    float wb[2][4];
#pragma unroll
    for (int nt = 0; nt < 2; ++nt)
#pragma unroll
        for (int s = 0; s < 4; ++s) wb[nt][s] = w_a_up[(4 * s + quad) * 1024 + h * 256 + 32 * wave + 16 * nt + l15];
    const float bz0 = b_a[h * 256 + 32 * wave + l15], bz1 = b_a[h * 256 + 32 * wave + 16 + l15];
    __syncthreads();
    if (stop == 1) return;
#pragma unroll
    for (int mt = 0; mt < 4; ++mt) {
        f32x4 z0 = (f32x4){bz0, bz0, bz0, bz0}, z1 = (f32x4){bz1, bz1, bz1, bz1};
#pragma unroll
        for (int s = 0; s < 4; ++s) { const float a = gaS[(16 * mt + l15) * 16 + 4 * s + quad];
            z0 = __builtin_amdgcn_mfma_f32_16x16x4f32(a, wb[0][s], z0, 0, 0, 0); z1 = __builtin_amdgcn_mfma_f32_16x16x4f32(a, wb[1][s], z1, 0, 0, 0); }
#pragma unroll
        for (int r = 0; r < 4; ++r) { ZS[(16 * mt + 4 * quad + r) * 256 + 32 * wave + l15] = z0[r]; ZS[(16 * mt + 4 * quad + r) * 256 + 32 * wave + 16 + l15] = z1[r]; }
    }
    __syncthreads();
    const int k = tid & 255, half = tid >> 8, col = h * 256 + k;
    {
        float s = 0.f;
#pragma unroll 8
        for (int t = 32 * half; t < 32 * half + 32; ++t) { const float la = logsig16(ZS[t * 256 + k]); ZS[t * 256 + k] = la; s += la; }
        partS[half * 256 + k] = s;
    }
    __syncthreads();
    if (stop == 2) return;
    {
        const float p0 = partS[k], p1 = partS[256 + k], blast = p0 + p1;
        float bc = half ? p0 : 0.f;
        const float dec = __expf(blast);
        if (half == 0) *(float*)(CHK + hn * CHK_BYTES + 65536 + k * 4) = dec;
        const bf16* qp = PROJ + (row0 + 32 * half) * NINP + PC_GQ + col; const bf16* kp = PROJ + (row0 + 32 * half) * NINP + PC_GK + col;
        unsigned qk[32];
#pragma unroll
        for (int t = 0; t < 32; ++t) qk[t] = (unsigned)qp[(size_t)t * NINP] | ((unsigned)kp[(size_t)t * NINP] << 16);
        u32x4 kdw[4];
#pragma unroll
        for (int q4 = 0; q4 < 4; ++q4) {
            float kd[8];
#pragma unroll
            for (int j = 0; j < 8; ++j) {
                const int t = 32 * half + 8 * q4 + j;
                bc += ZS[t * 256 + k];
                const float qv = bflo(qk[8 * q4 + j]) * 0.0625f, kv = bfhi(qk[8 * q4 + j]);
                const float eb = __expf(bc), qg = qv * eb, kg = kv * __builtin_amdgcn_rcpf(eb);
                kd[j] = kg * dec;
                *(LAS bf16*)(scr + GL_QG + t * GL_PITCH + k * 2) = (bf16)(pkbf(qg, 0.f) & 0xffffu);
                *(LAS bf16*)(scr + GL_KG + t * GL_PITCH + k * 2) = (bf16)(pkbf(kg, 0.f) & 0xffffu);
            }
            kdw[q4].x = pkbf(kd[0], kd[1]); kdw[q4].y = pkbf(kd[2], kd[3]); kdw[q4].z = pkbf(kd[4], kd[5]); kdw[q4].w = pkbf(kd[6], kd[7]);
        }
#pragma unroll
        for (int q4 = 0; q4 < 4; ++q4) {
            const int off = ((((k >> 4) * 2 + half) * 64) + q4 * 16 + (k & 15)) * 16;
            *(u32x4*)(CHK + hn * CHK_BYTES + 32768 + off) = kdw[q4];
        }
    }
    __syncthreads();
    if (stop == 3) return;
#pragma unroll
    for (int g8 = 0; g8 < 8; ++g8) {
        const int off = ((((tid >> 4) * 2 + (g8 >> 2)) * 64) + (g8 & 3) * 16 + (tid & 15)) * 16;
        *(LAS u32x4*)(scr + GL_VTF + off) = wv[g8];
        *(u32x4*)(VTF + hn * 65536 + off) = wv[g8];
    }
#pragma unroll
    for (int i = 0; i < 4; ++i) {
        const int f = tid + 512 * i, frag = f >> 6, ln = f & 63, fl = ln & 15, fq = ln >> 4, mt = frag >> 3, st = frag & 7, t = 16 * mt + fl;
        const u32x2 lo = *(const LAS u32x2*)(scr + GL_QG + t * GL_PITCH + (32 * st + 4 * fq) * 2), hi = *(const LAS u32x2*)(scr + GL_QG + t * GL_PITCH + (32 * st + 16 + 4 * fq) * 2);
        *(u32x4*)(CHK + hn * CHK_BYTES + (size_t)f * 16) = (u32x4){lo.x, lo.y, hi.x, hi.y};
    }
    f32x4 a0 = (f32x4){0.f, 0.f, 0.f, 0.f}, a1 = a0;
    const int mt = wave >> 1, nt0 = 2 * (wave & 1);
#pragma unroll
    for (int st = 0; st < 8; ++st) {
        const bf16x8 a = *(const LAS bf16x8*)(scr + GL_QG + (16 * mt + l15) * GL_PITCH + (32 * st + 8 * quad) * 2);
        const bf16x8 b0 = *(const LAS bf16x8*)(scr + GL_KG + (16 * nt0 + l15) * GL_PITCH + (32 * st + 8 * quad) * 2);
        const bf16x8 b1 = *(const LAS bf16x8*)(scr + GL_KG + (16 * (nt0 + 1) + l15) * GL_PITCH + (32 * st + 8 * quad) * 2);
        a0 = MFMA16(a, b0, a0); a1 = MFMA16(a, b1, a1);
    }
    __syncthreads();
    if (stop == 4) return;
#pragma unroll
    for (int r = 0; r < 4; ++r) {
        const int t = 16 * mt + 4 * quad + r, s0 = 16 * nt0 + l15, s1 = s0 + 16;
        *(LAS bf16*)(scr + GL_AM + t * AM_PITCH + s0 * 2) = (bf16)(pkbf(s0 <= t ? a0[r] : 0.f, 0.f) & 0xffffu);
        *(LAS bf16*)(scr + GL_AM + t * AM_PITCH + s1 * 2) = (bf16)(pkbf(s1 <= t ? a1[r] : 0.f, 0.f) & 0xffffu);
    }
    __syncthreads();
    for (int vti = 0; vti < 4; ++vti) {
        const int vt = 4 * wave + vti;
        const bf16x8 b0 = *(const LAS bf16x8*)(scr + GL_VTF + ((vt * 2 + 0) * 64 + lane) * 16), b1 = *(const LAS bf16x8*)(scr + GL_VTF + ((vt * 2 + 1) * 64 + lane) * 16);
#pragma unroll
        for (int m2 = 0; m2 < 4; ++m2) {
            const bf16x8 x0 = *(const LAS bf16x8*)(scr + GL_AM + (16 * m2 + l15) * AM_PITCH + (8 * quad) * 2), x1 = *(const LAS bf16x8*)(scr + GL_AM + (16 * m2 + l15) * AM_PITCH + (32 + 8 * quad) * 2);
            f32x4 acc = (f32x4){0.f, 0.f, 0.f, 0.f};
            acc = MFMA16(b0, x0, acc); acc = MFMA16(b1, x1, acc);
            u32x2 w; w.x = pkbf(acc[0], acc[1]); w.y = pkbf(acc[2], acc[3]);
            *(u32x2*)(OIA + (row0 + 16 * m2 + l15) * 2048 + h * 512 + 16 * vt + 4 * quad) = w;
        }
    }
    __syncthreads();
}

constexpr int SC_KD = 0, SC_DEC = 32768, SC_VT = 33792, SC_BUF = 35840;
constexpr int SC_NP = SC_BUF / 16, SC_NC = (32768 + 1024) / 16;
DI u32x4 gload16(const unsigned char* p) { u32x4 r; asm volatile("global_load_dwordx4 %0, %1, off" : "=v"(r) : "v"(p) : "memory"); return r; }
DI void scan_issue(u32x4 (&r)[5], const unsigned char* CHK, const unsigned char* VTF, size_t hn, int c, int lt) {
    const unsigned char* a = CHK + hn * CHK_BYTES + 32768; const unsigned char* b = VTF + hn * 65536 + 2048 * c - (size_t)SC_NC * 16;
#pragma unroll
    for (int i = 0; i < 5; ++i) { const int p = lt + 448 * i; r[i] = gload16((p < SC_NC ? a : b) + (size_t)p * 16); }
}
#define SCAN_WAIT(r, N) asm volatile("s_waitcnt vmcnt(" #N ")" : "+v"(r[0]), "+v"(r[1]), "+v"(r[2]), "+v"(r[3]), "+v"(r[4]) :: "memory")
DI void scan_commit(const u32x4 (&r)[5], LAS unsigned char* buf, int lt) {
#pragma unroll
    for (int i = 0; i < 5; ++i) *(LAS u32x4*)(buf + (lt + 448 * i) * 16) = r[i];
}
DI void gla_scan_block(int h, int c, const unsigned char* CHK, const unsigned char* VTF, unsigned char* SPF, float* outS, LAS unsigned char* scr, int tid) {
    const int wave = tid >> 6, lane = tid & 63, l15 = lane & 15, quad = lane >> 4;
    LAS unsigned char* buf0 = scr; LAS unsigned char* buf1 = scr + SC_BUF;
    const size_t hn0 = (size_t)h * 128;
    if (wave >= 1) {
        const int lt = tid - 64;
        u32x4 r0[5], r1[5], r2[5], r3[5];
        scan_issue(r0, CHK, VTF, hn0, c, lt); SCAN_WAIT(r0, 0); scan_commit(r0, buf0, lt);
        scan_issue(r0, CHK, VTF, hn0 + 1, c, lt); scan_issue(r1, CHK, VTF, hn0 + 2, c, lt); scan_issue(r2, CHK, VTF, hn0 + 3, c, lt); scan_issue(r3, CHK, VTF, hn0 + 4, c, lt);
        __syncthreads();
#define SCAN_STEP(r, buf, nn) do { SCAN_WAIT(r, 15); scan_commit(r, buf, lt); { const int n5 = (nn) < 128 ? (nn) : 127; scan_issue(r, CHK, VTF, hn0 + n5, c, lt); } __syncthreads(); } while (0)
        for (int n = 0; n < 128; n += 4) {
            SCAN_STEP(r0, buf1, n + 5);
            SCAN_STEP(r1, buf0, n + 6);
            SCAN_STEP(r2, buf1, n + 7);
            SCAN_STEP(r3, buf0, n + 8);
        }
#undef SCAN_STEP
        SCAN_WAIT(r0, 0); SCAN_WAIT(r1, 0); SCAN_WAIT(r2, 0); SCAN_WAIT(r3, 0);
    } else {
        f32x4 S[16];
#pragma unroll
        for (int kt = 0; kt < 16; ++kt) S[kt] = (f32x4){0.f, 0.f, 0.f, 0.f};
        __syncthreads();
        unsigned char* sp_out = SPF + ((hn0 * 32 + c) * 8) * 1024 + lane * 16;
        for (int n = 0; n < 128; ++n) {
            const LAS unsigned char* buf = (n & 1) ? buf1 : buf0;
#define SC_SB() __builtin_amdgcn_sched_barrier(0)
#define SC_LK(f, dcv, q) do { _Pragma("unroll") for (int i = 0; i < 8; ++i) f[i] = *(const LAS bf16x8*)(buf + SC_KD + ((8 * (q) + i) * 64 + lane) * 16); \
        _Pragma("unroll") for (int i = 0; i < 4; ++i) dcv[i] = *(const LAS f32x4*)(buf + SC_DEC + (16 * (4 * (q) + i) + 4 * quad) * 4); } while (0)
#define SC_MU(f, dcv, q) do { _Pragma("unroll") for (int i = 0; i < 4; ++i) S[4 * (q) + i] = MFMA16(f[2 * i], v0, S[4 * (q) + i] * dcv[i]); \
        _Pragma("unroll") for (int i = 0; i < 4; ++i) S[4 * (q) + i] = MFMA16(f[2 * i + 1], v1, S[4 * (q) + i]); } while (0)
            bf16x8 fa[8], fb[8]; f32x4 da[4], db[4];
            SC_LK(fa, da, 0); SC_LK(fb, db, 1);
            const bf16x8 v0 = *(const LAS bf16x8*)(buf + SC_VT + lane * 16), v1 = *(const LAS bf16x8*)(buf + SC_VT + (64 + lane) * 16);
#pragma unroll
            for (int st = 0; st < 8; ++st) {
                u32x4 pw; pw.x = pkbf(S[2 * st][0], S[2 * st][1]); pw.y = pkbf(S[2 * st][2], S[2 * st][3]); pw.z = pkbf(S[2 * st + 1][0], S[2 * st + 1][1]); pw.w = pkbf(S[2 * st + 1][2], S[2 * st + 1][3]);
                *(u32x4*)(sp_out + (size_t)n * (32 * 8 * 1024) + st * 1024) = pw;
            }
            SC_SB(); SC_MU(fa, da, 0); SC_SB(); SC_LK(fa, da, 2);
            SC_SB(); SC_MU(fb, db, 1); SC_SB(); SC_LK(fb, db, 3);
            SC_SB(); SC_MU(fa, da, 2);
            SC_SB(); SC_MU(fb, db, 3);
#undef SC_SB
#undef SC_LK
#undef SC_MU
            __syncthreads();
        }
        float* sp = outS + (size_t)h * 256 * 512 + 16 * c + l15;
#pragma unroll
        for (int kt = 0; kt < 16; ++kt)
#pragma unroll
            for (int r = 0; r < 4; ++r) sp[(size_t)(16 * kt + 4 * quad + r) * 512] = S[kt][r];
    }
}

DI void gla_sample_unit(int b, int h, const bf16* PROJ, const float* w_a_up, const float* b_a, const float* g_gla, const float* st0, float* stN, bf16* MIX, LAS unsigned char* scr, int tid) {
    LAS float* qgS = (LAS float*)scr; LAS float* kgS = qgS + 1024; LAS float* kdS = kgS + 1024; LAS float* decS = kdS + 1024; LAS float* vS = decS + 256;
    LAS float* AS = vS + 2048; LAS float* part = AS + 64; LAS float* red = part + 8192;
    const size_t row0 = (size_t)TP + 4 * b;
    const int grp = tid >> 7, c = tid & 127;
    const size_t sb = ((size_t)(b * 4 + h) * 256 + 64 * grp) * 512 + 4 * c;
    f32x4 sA[16], sB[16];
#pragma unroll
    for (int i = 0; i < 16; ++i) sA[i] = __builtin_nontemporal_load((const f32x4*)(st0 + sb + (size_t)i * 512));
    if (tid < 256) {
        const int k = tid, col = h * 256 + k;
        float z[4];
#pragma unroll
        for (int t = 0; t < 4; ++t) z[t] = b_a[col];
#pragma unroll
        for (int r = 0; r < 16; ++r) { const float w = w_a_up[r * 1024 + col];
#pragma unroll
            for (int t = 0; t < 4; ++t) z[t] += bf2f(PROJ[(row0 + t) * NINP + PC_GA + r]) * w; }
        float bt[4], bs = 0.f;
#pragma unroll
        for (int t = 0; t < 4; ++t) { bs += logsig16(z[t]); bt[t] = bs; }
#pragma unroll
        for (int t = 0; t < 4; ++t) {
            const float qv = bf2f(PROJ[(row0 + t) * NINP + PC_GQ + col]) * 0.0625f, kv = bf2f(PROJ[(row0 + t) * NINP + PC_GK + col]);
            qgS[t * 256 + k] = qv * __expf(bt[t]); kgS[t * 256 + k] = kv * __expf(-bt[t]); kdS[t * 256 + k] = kv * __expf(bs - bt[t]);
        }
        decS[k] = __expf(bs);
    } else {
        const int tt = tid - 256;
#pragma unroll
        for (int i = 0; i < 8; ++i) { const int idx = tt + 256 * i; vS[idx] = bf2f(PROJ[(row0 + (idx >> 9)) * NINP + PC_GV + h * 512 + (idx & 511)]); }
    }
    __syncthreads();
    const int wave = tid >> 6, lane = tid & 63;
    for (int p = wave; p < 10; p += 8) {
        const int t = (p >= 6) ? 3 : (p >= 3) ? 2 : (p >= 1) ? 1 : 0, s = p - (t * (t + 1)) / 2;
        float a = 0.f;
#pragma unroll
        for (int i = 0; i < 4; ++i) a += qgS[t * 256 + lane + 64 * i] * kgS[s * 256 + lane + 64 * i];
        a = wave_sum(a);
        if (lane == 0) AS[t * 4 + s] = a;
    }
    __syncthreads();
    f32x4 vv[4], oa[4];
#pragma unroll
    for (int t = 0; t < 4; ++t) { vv[t] = *(const LAS f32x4*)(vS + t * 512 + 4 * c); oa[t] = (f32x4){0.f, 0.f, 0.f, 0.f}; }
#define GS_LOAD(buf, k0) do { _Pragma("unroll") for (int i = 0; i < 16; ++i) buf[i] = __builtin_nontemporal_load((const f32x4*)(st0 + sb + (size_t)((k0) + i) * 512)); } while (0)
#define GS_STEP(buf, k0) do { _Pragma("unroll") for (int i = 0; i < 16; ++i) { const int k = 64 * grp + (k0) + i; f32x4 sn = buf[i] * decS[k]; \
        _Pragma("unroll") for (int t = 0; t < 4; ++t) { sn += vv[t] * kdS[t * 256 + k]; oa[t] += buf[i] * qgS[t * 256 + k]; } \
        __builtin_nontemporal_store(sn, (f32x4*)(stN + sb + (size_t)((k0) + i) * 512)); } } while (0)
    GS_LOAD(sB, 16); GS_STEP(sA, 0);
    GS_LOAD(sA, 32); GS_STEP(sB, 16);
    GS_LOAD(sB, 48); GS_STEP(sA, 32);
    GS_STEP(sB, 48);
#undef GS_LOAD
#undef GS_STEP
#pragma unroll
    for (int t = 0; t < 4; ++t) *(LAS f32x4*)(part + (grp * 4 + t) * 512 + 4 * c) = oa[t];
    __syncthreads();
    {
        const int t = tid >> 7;
        f32x4 o = (f32x4){0.f, 0.f, 0.f, 0.f};
#pragma unroll
        for (int g = 0; g < 4; ++g) o += *(const LAS f32x4*)(part + (g * 4 + t) * 512 + 4 * c);
        for (int s = 0; s <= t; ++s) o += *(const LAS f32x4*)(vS + s * 512 + 4 * c) * AS[t * 4 + s];
        float ss = wave_sum((o.x * o.x + o.y * o.y) + (o.z * o.z + o.w * o.w));
        if (lane == 0) red[wave] = ss;
        __syncthreads();
        const float rstd = 1.0f / sqrtf((red[2 * t] + red[2 * t + 1]) * (1.0f / 512.0f) + NORM_EPS);
        const f32x4 gg = *(const f32x4*)(g_gla + 4 * c);
        const u32x2 gr = *(const u32x2*)(PROJ + (row0 + t) * NINP + PC_GR + h * 512 + 4 * c);
        const f32x4 r4 = (f32x4){silu_f(bflo(gr.x)), silu_f(bfhi(gr.x)), silu_f(bflo(gr.y)), silu_f(bfhi(gr.y))};
        const f32x4 y = (o * rstd) * gg * r4;
        u32x2 w; w.x = pkbf(y.x, y.y); w.y = pkbf(y.z, y.w);
        *(u32x2*)(MIX + (row0 + t) * D + h * 512 + 4 * c) = w;
    }
    __syncthreads();
}

DI void gla_out_unit(int n, int h, const unsigned char* CHK, const unsigned char* SPF, const bf16* OIA, const bf16* PROJ, const float* g_gla, bf16* MIX, LAS unsigned char* scr, int tid) {
    const int wave = tid >> 6, lane = tid & 63, l15 = lane & 15, quad = lane >> 4;
    const size_t hn = (size_t)h * 128 + n, row0 = (size_t)64 * n;
    LAS float* red = (LAS float*)(scr + 32768);
    bf16x8 af[4][4], ag[4][4];
    const unsigned char* sp = SPF + ((hn * 32 + 4 * wave) * 8) * 1024 + lane * 16;
#pragma unroll
    for (int vt = 0; vt < 4; ++vt)
#pragma unroll
        for (int st = 0; st < 4; ++st) { af[vt][st] = *(const bf16x8*)(sp + (vt * 8 + st) * 1024); ag[vt][st] = *(const bf16x8*)(sp + (vt * 8 + 4 + st) * 1024); }
#pragma unroll
    for (int i = 0; i < 4; ++i) { const int p = tid + 512 * i; *(LAS u32x4*)(scr + p * 16) = *(const u32x4*)(CHK + hn * CHK_BYTES + (size_t)p * 16); }
    __syncthreads();
    f32x4 acc[4][4];
#pragma unroll
    for (int vt = 0; vt < 4; ++vt)
#pragma unroll
        for (int mt = 0; mt < 4; ++mt) acc[vt][mt] = (f32x4){0.f, 0.f, 0.f, 0.f};
#pragma unroll
    for (int st = 0; st < 8; ++st) {
        bf16x8 bq[4];
#pragma unroll
        for (int mt = 0; mt < 4; ++mt) bq[mt] = *(const LAS bf16x8*)(scr + ((mt * 8 + st) * 64 + lane) * 16);
#pragma unroll
        for (int vt = 0; vt < 4; ++vt)
#pragma unroll
            for (int mt = 0; mt < 4; ++mt) acc[vt][mt] = MFMA16(st < 4 ? af[vt][st & 3] : ag[vt][st & 3], bq[mt], acc[vt][mt]);
    }
    float ss[4];
#pragma unroll
    for (int mt = 0; mt < 4; ++mt) {
        const bf16* op = OIA + (row0 + 16 * mt + l15) * 2048 + h * 512 + 64 * wave + 4 * quad;
        float s = 0.f;
#pragma unroll
        for (int vt = 0; vt < 4; ++vt) { acc[vt][mt] += ld4(op + 16 * vt); const f32x4 o = acc[vt][mt]; s += (o.x * o.x + o.y * o.y) + (o.z * o.z + o.w * o.w); }
        s += __shfl_xor(s, 16); s += __shfl_xor(s, 32);
        ss[mt] = s;
        if (quad == 0) red[wave * 64 + 16 * mt + l15] = s;
    }
    __syncthreads();
#pragma unroll
    for (int mt = 0; mt < 4; ++mt) {
        float tot = 0.f;
#pragma unroll
        for (int w = 0; w < 8; ++w) tot += red[w * 64 + 16 * mt + l15];
        const float rstd = 1.0f / sqrtf(tot * (1.0f / 512.0f) + NORM_EPS);
        const size_t row = row0 + 16 * mt + l15;
#pragma unroll
        for (int vt = 0; vt < 4; ++vt) {
            const int col = h * 512 + 64 * wave + 16 * vt + 4 * quad;
            const f32x4 gg = *(const f32x4*)(g_gla + 64 * wave + 16 * vt + 4 * quad);
            const u32x2 gr = *(const u32x2*)(PROJ + row * NINP + PC_GR + col);
            const f32x4 r4 = (f32x4){silu_f(bflo(gr.x)), silu_f(bfhi(gr.x)), silu_f(bflo(gr.y)), silu_f(bfhi(gr.y))};
            const f32x4 y = (acc[vt][mt] * rstd) * gg * r4;
            u32x2 w; w.x = pkbf(y.x, y.y); w.y = pkbf(y.z, y.w);
            *(u32x2*)(MIX + row * D + col) = w;
        }
    }
    (void)ss;
    __syncthreads();
}

struct CRow { f32x4 g[2], v[2]; };
DI CRow crow_bf16i(const bf16* p) { const u32x4 a = *(const u32x4*)p, c = *(const u32x4*)(p + 128); CRow r;
    r.g[0] = (f32x4){bflo(a.x), bfhi(a.x), bflo(a.y), bfhi(a.y)}; r.g[1] = (f32x4){bflo(a.z), bfhi(a.z), bflo(a.w), bfhi(a.w)};
    r.v[0] = (f32x4){bflo(c.x), bfhi(c.x), bflo(c.y), bfhi(c.y)}; r.v[1] = (f32x4){bflo(c.z), bfhi(c.z), bflo(c.w), bfhi(c.w)}; return r; }
DI CRow crow_f32(const float* p) { CRow r; r.g[0] = *(const f32x4*)p; r.g[1] = *(const f32x4*)(p + 4); r.v[0] = *(const f32x4*)(p + FF); r.v[1] = *(const f32x4*)(p + FF + 4); return r; }
DI CRow crow_zero() { CRow r; r.g[0] = r.g[1] = r.v[0] = r.v[1] = (f32x4){0.f, 0.f, 0.f, 0.f}; return r; }
struct CTaps { f32x4 wg[3][2], wv[3][2], bg[2], bv[2]; };
DI CTaps ctaps_load(const float* wc, const float* bc, int f) { CTaps t;
#pragma unroll
    for (int hh = 0; hh < 2; ++hh) {
#pragma unroll
        for (int j = 0; j < 3; ++j) { t.wg[j][hh] = *(const f32x4*)(wc + (size_t)j * F2 + f + 4 * hh); t.wv[j][hh] = *(const f32x4*)(wc + (size_t)j * F2 + FF + f + 4 * hh); }
        t.bg[hh] = *(const f32x4*)(bc + f + 4 * hh); t.bv[hh] = *(const f32x4*)(bc + FF + f + 4 * hh);
    }
    return t; }
DI float silu_r(float x) { return x * __builtin_amdgcn_rcpf(1.0f + __expf(-x)); }
DI void conv_half(const CTaps& t, int hh, const f32x4& p2g, const f32x4& p1g, const f32x4& cg, const f32x4& p2v, const f32x4& p1v, const f32x4& cv, unsigned& w0, unsigned& w1) {
    const f32x4 g = t.bg[hh] + t.wg[0][hh] * p2g + t.wg[1][hh] * p1g + t.wg[2][hh] * cg;
    const f32x4 v = t.bv[hh] + t.wv[0][hh] * p2v + t.wv[1][hh] * p1v + t.wv[2][hh] * cv;
    w0 = pkbf(silu_r(g.x) * v.x, silu_r(g.y) * v.y); w1 = pkbf(silu_r(g.z) * v.z, silu_r(g.w) * v.w);
}
DI u32x4 conv_out(const CTaps& t, const CRow& p2, const CRow& p1, const CRow& c) { u32x4 w; unsigned* wp = (unsigned*)&w;
#pragma unroll
    for (int hh = 0; hh < 2; ++hh) conv_half(t, hh, p2.g[hh], p1.g[hh], c.g[hh], p2.v[hh], p1.v[hh], c.v[hh], wp[2 * hh], wp[2 * hh + 1]);
    return w; }
DI float dpp_shr1(float x) { return __builtin_bit_cast(float, __builtin_amdgcn_update_dpp(0, __builtin_bit_cast(int, x), 0x111, 0xf, 0xf, true)); }
DI float dpp_shr2(float x) { return __builtin_bit_cast(float, __builtin_amdgcn_update_dpp(0, __builtin_bit_cast(int, x), 0x112, 0xf, 0xf, true)); }
DI f32x4 dpp_shr1(f32x4 x) { return (f32x4){dpp_shr1(x[0]), dpp_shr1(x[1]), dpp_shr1(x[2]), dpp_shr1(x[3])}; }
DI f32x4 dpp_shr2(f32x4 x) { return (f32x4){dpp_shr2(x[0]), dpp_shr2(x[1]), dpp_shr2(x[2]), dpp_shr2(x[3])}; }
DI u32x4 pack8(const f32x4& a, const f32x4& b) { u32x4 w; w.x = pkbf(a[0], a[1]); w.y = pkbf(a[2], a[3]); w.z = pkbf(b[0], b[1]); w.w = pkbf(b[2], b[3]); return w; }
struct EpiConv {
    static constexpr bool PERM = true, AFTER_DRAIN = false;
    bf16* Gm; bf16* UE; bf16* US; const float* wc; const float* bc; float* ocp;
    DI void operator()(const f32x4 (&acc)[2][2][4][2], const pg8::Unit& u, int wr, int wcol, int fr, int fq) const {
        const int cw = wcol * 32 + 8 * fq, ucol = 256 * u.pn + cw, f = 128 * u.pn + cw, rowb = u.pm * 256 + wr * 64 + fr;
        if (u.pm >= 32) {
#pragma unroll
            for (int ai = 0; ai < 2; ++ai)
#pragma unroll
                for (int m = 0; m < 4; ++m) { bf16* rp = US + (size_t)(rowb + 128 * ai + 16 * m - TP) * F2 + ucol;
                    *(u32x4*)rp = pack8(acc[ai][0][m][0], acc[ai][0][m][1]); *(u32x4*)(rp + 128) = pack8(acc[ai][1][m][0], acc[ai][1][m][1]); }
            return;
        }
        const CTaps t = ctaps_load(wc, bc, f);
        const bool edge = fr < 2 || fr >= 14; const int slot = fr < 2 ? fr : fr - 12;
#pragma unroll
        for (int ai = 0; ai < 2; ++ai)
#pragma unroll
            for (int m = 0; m < 4; ++m) {
                const int row = rowb + 128 * ai + 16 * m;
                u32x4 w; unsigned* wp = (unsigned*)&w;
#pragma unroll
                for (int hh = 0; hh < 2; ++hh) { const f32x4 cg = acc[ai][0][m][hh], cv = acc[ai][1][m][hh];
                    conv_half(t, hh, dpp_shr2(cg), dpp_shr1(cg), cg, dpp_shr2(cv), dpp_shr1(cv), cv, wp[2 * hh], wp[2 * hh + 1]);
                    __builtin_amdgcn_sched_barrier(0); }
                *(u32x4*)(Gm + (size_t)row * FF + f) = w;
                if (edge) { bf16* ep = UE + ((size_t)(row >> 4) * 4 + slot) * F2 + ucol; *(u32x4*)ep = pack8(acc[ai][0][m][0], acc[ai][0][m][1]); *(u32x4*)(ep + 128) = pack8(acc[ai][1][m][0], acc[ai][1][m][1]); }
                if (row >= TP - 2) { float* oc = ocp + (size_t)(row - (TP - 2)) * F2 + f; *(f32x4*)oc = acc[ai][0][m][0]; *(f32x4*)(oc + 4) = acc[ai][0][m][1]; *(f32x4*)(oc + FF) = acc[ai][1][m][0]; *(f32x4*)(oc + FF + 4) = acc[ai][1][m][1]; }
            }
    }
};
struct CRaw { u32x4 a, c; };
DI CRaw craw_ld(const bf16* p) { CRaw r; r.a = *(const u32x4*)p; r.c = *(const u32x4*)(p + 128); return r; }
DI CRow crow_cvt(const CRaw& q) { CRow r; const u32x4 a = q.a, c = q.c;
    r.g[0] = (f32x4){bflo(a.x), bfhi(a.x), bflo(a.y), bfhi(a.y)}; r.g[1] = (f32x4){bflo(a.z), bfhi(a.z), bflo(a.w), bfhi(a.w)};
    r.v[0] = (f32x4){bflo(c.x), bfhi(c.x), bflo(c.y), bfhi(c.y)}; r.v[1] = (f32x4){bflo(c.z), bfhi(c.z), bflo(c.w), bfhi(c.w)}; return r; }
DI void conv_fix4(int strip, int g0, const bf16* UE, const float* wc, const float* bc, bf16* G, int lane) {
    const int f = 512 * strip + 8 * lane;
    if (f >= FF) return;
    const int ucol = 256 * (f >> 7) + (f & 127);
    const CTaps t = ctaps_load(wc, bc, f);
    CRow p2 = g0 ? crow_bf16i(UE + ((size_t)(g0 - 1) * 4 + 2) * F2 + ucol) : crow_zero();
    CRow p1 = g0 ? crow_bf16i(UE + ((size_t)(g0 - 1) * 4 + 3) * F2 + ucol) : crow_zero();
#pragma unroll 1
    for (int h = 0; h < 4; ++h) {
        CRaw e[4];
#pragma unroll
        for (int s = 0; s < 4; ++s) e[s] = craw_ld(UE + ((size_t)(g0 + h) * 4 + s) * F2 + ucol);
        const int r = 16 * (g0 + h);
        const CRow c0 = crow_cvt(e[0]), c1 = crow_cvt(e[1]);
        *(u32x4*)(G + (size_t)r * FF + f) = conv_out(t, p2, p1, c0);
        *(u32x4*)(G + (size_t)(r + 1) * FF + f) = conv_out(t, p1, c0, c1);
        p2 = crow_cvt(e[2]); p1 = crow_cvt(e[3]);
    }
}
DI void conv_sample(int strip, int b, const bf16* US, const float* st, const float* wc, const float* bc, bf16* G, float* o0, float* o1, int lane) {
    const int f = 512 * strip + 8 * lane;
    if (f >= FF) return;
    const int ucol = 256 * (f >> 7) + (f & 127);
    const CTaps t = ctaps_load(wc, bc, f);
    CRow p2 = crow_f32(st + f), p1 = crow_f32(st + F2 + f), cu[4];
#pragma unroll
    for (int i = 0; i < 4; ++i) cu[i] = crow_bf16i(US + (size_t)(4 * b + i) * F2 + ucol);
#pragma unroll
    for (int i = 0; i < 4; ++i) {
        *(u32x4*)(G + (size_t)(TP + 4 * b + i) * FF + f) = conv_out(t, p2, p1, cu[i]);
        p2 = p1; p1 = cu[i];
    }
    *(f32x4*)(o0 + f) = cu[2].g[0]; *(f32x4*)(o0 + f + 4) = cu[2].g[1]; *(f32x4*)(o0 + FF + f) = cu[2].v[0]; *(f32x4*)(o0 + FF + f + 4) = cu[2].v[1];
    *(f32x4*)(o1 + f) = cu[3].g[0]; *(f32x4*)(o1 + f + 4) = cu[3].g[1]; *(f32x4*)(o1 + FF + f) = cu[3].v[0]; *(f32x4*)(o1 + FF + f + 4) = cu[3].v[1];
}

__global__ void __launch_bounds__(NWAVES * 64, 2) hymba_fwd(Args args) {
    extern __shared__ __attribute__((aligned(16))) unsigned char lds_raw[];
    LAS unsigned char* lds = (LAS unsigned char*)lds_raw;
    const int tid = threadIdx.x, lane = tid & 63, wave = __builtin_amdgcn_readfirstlane(tid >> 6);
    const int G = gridDim.x, bid = blockIdx.x;
    unsigned char* ws = args.ws;
    unsigned* ctl = (unsigned*)(ws + WS_CTL);
    for (int u = tid; u < LDS_SCR / 4; u += NWAVES * 64) ((LAS unsigned*)lds)[u] = 0u;
    __syncthreads();
    XcdBarrier bar = xcd_barrier_post(ctl + CW_BAR + args.li * XCD_BAR_WORDS, (volatile LAS unsigned*)lds + 8);
    LAS unsigned char* scr = lds + LDS_SCR;
    const int gw = bid * NWAVES + wave, NGW = G * NWAVES;

    const float* xp = args.in[I_XP]; const float* xs = args.in[I_XS];
    float* MOD = (float*)(ws + WS_MOD);
    bf16* WIN = (bf16*)(ws + WS_WIN); bf16* WO = (bf16*)(ws + WS_WO); bf16* WUP = (bf16*)(ws + WS_WUP); bf16* WDN = (bf16*)(ws + WS_WDN);
    bf16* X1 = (bf16*)(ws + WS_X1); bf16* X2 = (bf16*)(ws + WS_X2); bf16* H = (bf16*)(ws + WS_H); bf16* MIX = (bf16*)(ws + WS_MIX); bf16* PROJ = (bf16*)(ws + WS_PROJ);
    unsigned char* CHK = ws + WS_CHK; unsigned char* VTF = ws + WS_VTF;
    bf16* OIA = (bf16*)(ws + WS_OIA); unsigned char* SPF = ws + WS_SPF; bf16* UE = (bf16*)(ws + WS_UE); bf16* US = (bf16*)(ws + WS_US); bf16* GB = (bf16*)(ws + WS_G);
    float* out = args.out; float* SLAB = (float*)(ws + WS_SLAB);

    const int lo = args.ph_lo, hi = args.ph_hi;
#define IN(k) (lo <= (k) && (k) < hi)
#define SEAM(k) do { if (IN(k) && IN((k) + 1)) xcd_barrier(bar); } while (0)

    if (IN(0)) {
        if (bid < 192) adaln_block(8 * bid, args.in[I_CS], args.in[I_CP], args.in[I_WADA], args.in[I_BADA], MOD, scr, opq(tid));
        LAS unsigned char* ws_scr = scr + wave * 8192;
        constexpr int I_I = 64 * (NINP / 64), I_O = 64 * 64;
        constexpr int NIT = I_I + I_O, BATCH = 32;
        for (int rnd = 0;; ++rnd) {
            volatile LAS unsigned* slot = (volatile LAS unsigned*)lds + 16 + (rnd & 1);
            if (tid == 0) *slot = __hip_atomic_fetch_add(ctl + CW_WORK, (unsigned)BATCH, __ATOMIC_RELAXED, __HIP_MEMORY_SCOPE_AGENT);
            __syncthreads();
            const int base = (int)*slot;
            if (base >= NIT) break;
#pragma unroll 1
            for (int it = base + wave; it < base + BATCH && it < NIT; it += NWAVES) {
                if (it < I_I) tr_win(args.in[I_WIN], WIN, it, ws_scr, opq(lane));
                else tr_plain(args.in[I_WO], D, D, WO, it - I_I, ws_scr, opq(lane));
            }
        }
    }
    if (IN(0) && IN(2)) xcd_barrier(bar);
    if (IN(2)) {
        for (int r = gw; r < MROWS; r += NGW) {
            const float* xr = r < TP ? xp + (size_t)r * D : xs + (size_t)(r - TP) * D;
            const float* m = MOD + (size_t)(r < TP ? 128 : ((r - TP) >> 2)) * NMOD;
            modnorm_row(xr, args.in[I_GNORM], m + 4096, m, H + (size_t)r * D, opq(lane));
        }
    }
    SEAM(2);
    if (IN(3)) {
        pg8::Gemm g{H, WIN, MROWS, NINP, D}; pg8::StaticOrder S; S.init(MROWS, NINP, G, bid, D);
        pg8::EpiBf16 E{PROJ, NINP};
        pg8::gemm_phase<pg8::EpiBf16, pg8::StaticOrder, true, true>(scr, g, S, E);
    }
    SEAM(3);
    if (IN(4)) {
        for (int rnd = 0;; ++rnd) {
            volatile LAS unsigned* slot = (volatile LAS unsigned*)lds + 16 + (rnd & 1);
            if (tid == 0) *slot = __hip_atomic_fetch_add(ctl + CW_WORK4, 1u, __ATOMIC_RELAXED, __HIP_MEMORY_SCOPE_AGENT);
            __syncthreads();
            const int id = (int)*slot;
            if (id >= 1024) break;
            const int u = id >> 1;
            if (id & 1) { if (!(args.pad & 4)) gla_local_unit(u & 127, u >> 7, PROJ, args.in[I_WAUP], args.in[I_BA], CHK, VTF, OIA, scr, opq(tid), (args.pad >> 4) & 7); }
            else { if (!(args.pad & 8)) gla_sample_unit(u >> 2, u & 3, PROJ, args.in[I_WAUP], args.in[I_BA], args.in[I_GGLA], args.in[I_SGLA], out + O_GLA_S, MIX, scr, opq(tid)); }
        }
    }
    SEAM(4);
    if (IN(5)) {
        if (bid < 128) { if (!(args.pad & 1)) {
            const int x = bid & 7, i = bid >> 3;
            gla_scan_block(x >> 1, (x & 1) * 16 + i, CHK, VTF, SPF, out + O_GLA_P, scr, opq(tid)); __syncthreads(); }
        }
        if (!(args.pad & 2)) for (int rnd = 0;; ++rnd) {
            volatile LAS unsigned* slot = (volatile LAS unsigned*)lds + 16 + (rnd & 1);
            if (tid == 0) *slot = __hip_atomic_fetch_add(ctl + CW_WORK5, 1u, __ATOMIC_RELAXED, __HIP_MEMORY_SCOPE_AGENT);
            __syncthreads();
            const int id = (int)*slot;
            constexpr int NB_U = (64 * (F2 / 64)) / (2 * NWAVES);
            if (id >= 9 * 256) break;
            const int g = id / 9, r = id % 9;
            if (r % 3 == 0) {
                const int unit = 3 * g + r / 3;
                if (unit < 256) swa_prompt_unit(unit >> 2, unit & 3, PROJ, args.in[I_SINK], MIX, out + O_K_P, out + O_V_P, scr, opq(tid));
                else { const int u = unit - 256; swa_sample_unit(u >> 2, u & 3, PROJ, args.in[I_SK], args.in[I_SV], args.in[I_SINK], MIX, out + O_K_S, out + O_V_S, scr, opq(tid)); }
            } else {
                const int cb = 6 * g + (r - r / 3 - 1);
                if (cb < NB_U) tr_wup2(args.in[I_WUP], WUP, cb * 2 * NWAVES + wave, cb * 2 * NWAVES + NWAVES + wave, scr + wave * 8192, opq(lane));
                __syncthreads();
            }
        }
    }
    SEAM(5);
    if (IN(6)) {
        for (int u = bid; u < 512; u += G) gla_out_unit(u & 127, u >> 7, CHK, SPF, OIA, PROJ, args.in[I_GGLA], MIX, scr, opq(tid));
    }
    SEAM(6);
    if (IN(7)) {
        pg8::Gemm g{MIX, WO, MROWS, D, D}; pg8::TailOrder S; S.init(G, bid, D);
        pg8::EpiResid<false> E{xp, MOD + 2 * D, X1, SLAB, D / 128};
        pg8::gemm_phase<pg8::EpiResid<false>, pg8::TailOrder, true, true>(scr, g, S, E);
    }
    SEAM(7);
    if (IN(8)) {
        for (int r = gw; r < MROWS; r += NGW) {
            const float* m = MOD + (size_t)(r < TP ? 128 : ((r - TP) >> 2)) * NMOD;
            if (r >= TP) { slab_reduce_row(xs + (size_t)(r - TP) * D, m + 2 * D, SLAB + (size_t)(r - TP) * D, X1 + (size_t)r * D, opq(lane)); VM_WAIT(); }
            modnorm_row(X1 + (size_t)r * D, args.in[I_GNORM] + D, m + 4 * D, m + 3 * D, H + (size_t)r * D, opq(lane));
        }
    }
    SEAM(8);
    if (IN(9)) {
        constexpr int GG = 244;
        if (bid < GG || G <= GG) {
            pg8::Gemm g{H, WUP, MROWS, F2, D}; pg8::StaticOrder S; S.init(MROWS, F2, G <= GG ? G : GG, bid, D);
            EpiConv E{GB, UE, US, args.in[I_WCONV], args.in[I_BCONV], out + O_CONV_P};
            pg8::gemm_phase<EpiConv, pg8::StaticOrder, true, true>(scr, g, S, E);
        }
        if (bid >= GG || G <= GG) {
            LAS unsigned char* ws_scr = scr + wave * 8192;
            const int w0 = G <= GG ? gw : (bid - GG) * NWAVES + wave, nw = G <= GG ? NGW : (G - GG) * NWAVES;
#pragma unroll 1
            for (int it = w0; it < (FF / 64) * 64; it += nw) tr_plain(args.in[I_WDN], FF, D, WDN, it, ws_scr, opq(lane));
        }
    }
    SEAM(9);
    if (IN(10)) {
        for (int it = gw; it < 2 * 128 * 22; it += NGW) {
            const int k = it >> 1, b = k / 22, strip = k % 22;
            if (it & 1) conv_fix4(strip, 4 * b, UE, args.in[I_WCONV], args.in[I_BCONV], GB, opq(lane));
            else conv_sample(strip, b, US, args.in[I_SCONV] + (size_t)b * 2 * F2, args.in[I_WCONV], args.in[I_BCONV], GB, out + O_CONV_S + (size_t)b * 2 * F2, out + O_CONV_S + (size_t)(b * 2 + 1) * F2, opq(lane));
        }
    }
    SEAM(10);
    if (IN(11)) {
        pg8::Gemm g{GB, WDN, MROWS, D, FF}; pg8::TailOrder S; S.init(G, bid, FF);
        pg8::EpiResid<true> E{X1, MOD + 5 * D, X2, SLAB, FF / 128};
        pg8::gemm_phase<pg8::EpiResid<true>, pg8::TailOrder, true, true>(scr, g, S, E);
    }
    SEAM(11);
    if (IN(12)) {
        for (int r = gw; r < MROWS; r += NGW) {
            if (r >= TP) { slab_reduce_row(X1 + (size_t)r * D, MOD + (size_t)((r - TP) >> 2) * NMOD + 5 * D, SLAB + (size_t)(r - TP) * D, X2 + (size_t)r * D, opq(lane)); VM_WAIT(); }
            finalnorm_row(X2 + (size_t)r * D, out + O_Y + (size_t)r * D, args.in[I_GFIN], opq(lane));
        }
    }
#undef IN
#undef SEAM
}

#ifndef MK_N_LAUNCHES
#define MK_N_LAUNCHES 1
#endif
extern "C" void kernel_launch(void* const* d_in, const int* in_sizes, int n_in, void* d_out, int out_size, void* d_ws, size_t ws_size, hipStream_t stream) {
    static int grid = 0;
    if (grid == 0) {
        if (n_in != 22 || (size_t)out_size != O_END || ws_size < WS_END) { fprintf(stderr, "kernel_launch: unexpected shapes (n_in %d, out %d, ws %zu); nothing launched\n", n_in, out_size, ws_size); grid = -1; return; }
        int dev = 0, cus = 0, per_cu = 0;
        if (hipGetDevice(&dev) != hipSuccess || hipDeviceGetAttribute(&cus, hipDeviceAttributeMultiprocessorCount, dev) != hipSuccess) { grid = -1; return; }
        if (hipFuncSetAttribute((const void*)hymba_fwd, hipFuncAttributeMaxDynamicSharedMemorySize, LDS_BYTES) != hipSuccess) { fprintf(stderr, "kernel_launch: hipFuncSetAttribute failed\n"); grid = -1; return; }
        if (hipOccupancyMaxActiveBlocksPerMultiprocessor(&per_cu, (const void*)hymba_fwd, NWAVES * 64, LDS_BYTES) != hipSuccess || per_cu < 1) { fprintf(stderr, "kernel_launch: occupancy query says %d\n", per_cu); }
        (void)hipGetLastError();
        grid = cus;
        if (grid < 128) { fprintf(stderr, "kernel_launch: %d CUs: this kernel is built for a 256-CU device\n", grid); grid = -1; return; }
    }
    if (grid < 0) return;
    (void)hipMemsetAsync((char*)d_ws + WS_CTL, 0, CTL_ZERO_BYTES, stream);
    Args a{};
    for (int i = 0; i < 22; ++i) a.in[i] = (const float*)d_in[i];
    a.out = (float*)d_out; a.ws = (unsigned char*)d_ws;
#if defined(PROBE_A)
#ifndef PROBE_PAD
#define PROBE_PAD 0
#endif
    const int cuts[3][2] = {{0, PROBE_B}, {PROBE_A, PROBE_B}, {PROBE_B, 13}};
    for (int li = 0; li < 3; ++li) { a.ph_lo = cuts[li][0]; a.ph_hi = cuts[li][1]; a.li = li; a.pad = (li == 1) ? PROBE_PAD : 0; if (a.ph_lo < a.ph_hi) hipLaunchKernelGGL(hymba_fwd, dim3(grid), dim3(NWAVES * 64), LDS_BYTES, stream, a); }
#else
    a.ph_lo = 0; a.ph_hi = 13; a.li = 0;
    hipLaunchKernelGGL(hymba_fwd, dim3(grid), dim3(NWAVES * 64), LDS_BYTES, stream, a);
#endif
}
```

```cpp
#include <hip/hip_runtime.h>
#include <cstdio>
#include <cstdint>
namespace pg8 {
#define PG8_LAS __attribute__((address_space(3)))
typedef unsigned short bf16_t;
typedef short bf16x8 __attribute__((ext_vector_type(8)));
typedef float f32x4 __attribute__((ext_vector_type(4)));
typedef unsigned u32x4 __attribute__((ext_vector_type(4)));
constexpr int BM = 256, BK = 64, HALF = 128, HTB = HALF * BK * 2  , STAGE_BYTES = 8 * HTB, NXCD = 8, WGM = 8;

__host__ __device__ __forceinline__ int lds_byte(int r, int c) { const int st = (r >> 4) * 2 + (c >> 5), rr = r & 15, cc = c & 31, ob = rr * 64 + cc * 2; return st * 1024 + (ob ^ (((ob >> 9) & 1) << 5)); }
__host__ __device__ __forceinline__ void stage_rc(int b, int& R, int& C) { const int st = b / 1024, sb = b % 1024, swz = sb ^ (((sb >> 9) & 1) << 5); R = (st >> 1) * 16 + swz / 64; C = (st & 1) * 32 + (swz % 64) / 2; }
__host__ __device__ __forceinline__ int perm32(int rho) { const int n = rho >> 4, i = rho & 15; return 8 * (i >> 2) + 4 * n + (i & 3); }

struct Unit { int pm, pn, kt0, nt; };
struct Gemm { const bf16_t* A; const bf16_t* Bt; int M, N, K; };

struct StaticOrder {
    int nM, nN, nwg, G, c, ntk;
    __host__ __device__ void init(int M, int N, int G_, int c_, int K) { nM = M / BM; nN = N / BM; nwg = nM * nN; G = G_; c = c_; ntk = K / BK; }
    __host__ __device__ bool next(int i, Unit& u) const {
        const long L = (long)i * G + c; if (L >= nwg) return false;
        int wgid = (int)L; { const int q = nwg / NXCD, r = nwg % NXCD, xcd = wgid % NXCD, off = wgid / NXCD; wgid = (xcd < r ? xcd * (q + 1) : r * (q + 1) + (xcd - r) * q) + off; }
        const int nig = WGM * nN, gid = wgid / nig, fm = gid * WGM, gsz = (nM - fm) < WGM ? (nM - fm) : WGM;
        u.pm = fm + ((wgid % nig) % gsz); u.pn = (wgid % nig) / gsz; u.kt0 = 0; u.nt = ntk; return true;
    }
    __device__ __forceinline__ void a_ready(const Unit&) const {}
    __device__ __forceinline__ void done(const Unit&) const {}
};

typedef float f32x2_t __attribute__((ext_vector_type(2)));
typedef __bf16 bf16x2_t __attribute__((ext_vector_type(2)));
__device__ __forceinline__ unsigned cvt_pk_bf16(float lo, float hi) { const f32x2_t v = {lo, hi}; return __builtin_bit_cast(unsigned, __builtin_convertvector(v, bf16x2_t)); }

struct RowOrder {
    int n, c, ntk;
    __device__ __forceinline__ bool next(int i, Unit& u) const { if (i > 0 || c >= n) return false; u.pm = 0; u.pn = c; u.kt0 = 0; u.nt = ntk; return true; }
    __device__ __forceinline__ void a_ready(const Unit&) const {}
    __device__ __forceinline__ void done(const Unit&) const {}
};

struct TailOrder {
    StaticOrder P; int G, c, nd;
    __device__ __forceinline__ void init(int G_, int c_, int K) { P.init(8192, 4096, G_, c_, K); G = G_; c = c_; nd = K / 128; }
    __device__ __forceinline__ bool next(int i, Unit& u) const {
        if (G == 256 && (c & 1)) { if (i > 2) return false; i = (i == 0) ? 2 : i - 1; }
        const long L = (long)i * G + c;
        if (L < 512) return P.next(i, u);
        if (L >= 768) return false;
        const int su = (int)L - 512, ks = su >> 5, base = nd >> 3, rem = nd & 7;
        u.pn = su & 15; u.pm = 32 + ((su >> 4) & 1);
        u.kt0 = 2 * (ks * base + (ks < rem ? ks : rem)); u.nt = 2 * (base + (ks < rem ? 1 : 0));
        return true;
    }
    __device__ __forceinline__ void a_ready(const Unit&) const {}
    __device__ __forceinline__ void done(const Unit&) const {}
};

struct EpiF32 {
    static constexpr bool PERM = false, AFTER_DRAIN = false;
    float* C; int ldc; const float* bias;
    __device__ __forceinline__ void operator()(const f32x4 (&acc)[2][2][4][2], const Unit& u, int wr, int wc, int fr, int fq) const {
        const int row0 = u.pm * BM + wr * 64 + fr, col0 = u.pn * BM + wc * 32 + 4 * fq;
        f32x4 bv[2][2];
#pragma unroll
        for (int bj = 0; bj < 2; ++bj)
#pragma unroll
            for (int n = 0; n < 2; ++n) bv[bj][n] = *(const f32x4*)(bias + col0 + bj * HALF + n * 16);
#pragma unroll
        for (int ai = 0; ai < 2; ++ai)
#pragma unroll
            for (int m = 0; m < 4; ++m) { float* rowp = C + (size_t)(row0 + ai * HALF + m * 16) * ldc + col0;
#pragma unroll
                for (int bj = 0; bj < 2; ++bj)
#pragma unroll
                    for (int n = 0; n < 2; ++n) *(f32x4*)(rowp + bj * HALF + n * 16) = acc[ai][bj][m][n] + bv[bj][n]; }
    }
};
struct EpiBf16 {
    static constexpr bool PERM = true, AFTER_DRAIN = false;
    bf16_t* O; int ldc;
    __device__ __forceinline__ void operator()(const f32x4 (&acc)[2][2][4][2], const Unit& u, int wr, int wc, int fr, int fq) const {
        const int row0 = u.pm * BM + wr * 64 + fr, col0 = u.pn * BM + wc * 32 + 8 * fq;
#pragma unroll
        for (int ai = 0; ai < 2; ++ai)
#pragma unroll
            for (int m = 0; m < 4; ++m) { bf16_t* rowp = O + (size_t)(row0 + ai * HALF + m * 16) * ldc + col0;
#pragma unroll
                for (int bj = 0; bj < 2; ++bj) { const f32x4 v0 = acc[ai][bj][m][0], v1 = acc[ai][bj][m][1];
                    u32x4 w; w.x = cvt_pk_bf16(v0[0], v0[1]); w.y = cvt_pk_bf16(v0[2], v0[3]); w.z = cvt_pk_bf16(v1[0], v1[1]); w.w = cvt_pk_bf16(v1[2], v1[3]);
                    *(u32x4*)(rowp + bj * HALF) = w; } }
    }
};
template <bool BASE_BF16> struct EpiResid {
    static constexpr bool PERM = true, AFTER_DRAIN = false;
    const void* bp; const float* gate; bf16_t* out; bf16_t* slab; int nd;
    __device__ __forceinline__ void operator()(const f32x4 (&acc)[2][2][4][2], const Unit& u, int wr, int wc, int fr, int fq) const {
        const int row0 = u.pm * BM + wr * 64 + fr, col0 = u.pn * BM + wc * 32 + 8 * fq;
        if (u.pm < 32) {
            const float* grow = gate + (size_t)128 * 24576 + col0;
            f32x4 gv[2][2];
#pragma unroll
            for (int bj = 0; bj < 2; ++bj) { gv[bj][0] = *(const f32x4*)(grow + bj * HALF); gv[bj][1] = *(const f32x4*)(grow + bj * HALF + 4); }
#pragma unroll
            for (int ai = 0; ai < 2; ++ai)
#pragma unroll
                for (int mh = 0; mh < 2; ++mh) {
                    f32x4 x[2][2][2];
#pragma unroll
                    for (int mm = 0; mm < 2; ++mm)
#pragma unroll
                        for (int bj = 0; bj < 2; ++bj) { const size_t ro = (size_t)(row0 + ai * HALF + (2 * mh + mm) * 16) * 4096 + col0 + bj * HALF;
                            if (BASE_BF16) { const u32x4 b = *(const u32x4*)((const bf16_t*)bp + ro);
                                x[mm][bj][0] = (f32x4){__uint_as_float(b.x << 16), __uint_as_float(b.x & 0xffff0000u), __uint_as_float(b.y << 16), __uint_as_float(b.y & 0xffff0000u)};
                                x[mm][bj][1] = (f32x4){__uint_as_float(b.z << 16), __uint_as_float(b.z & 0xffff0000u), __uint_as_float(b.w << 16), __uint_as_float(b.w & 0xffff0000u)}; }
                            else { const float* p = (const float*)bp + ro; x[mm][bj][0] = *(const f32x4*)p; x[mm][bj][1] = *(const f32x4*)(p + 4); } }
#pragma unroll
                    for (int mm = 0; mm < 2; ++mm)
#pragma unroll
                        for (int bj = 0; bj < 2; ++bj) { const int m = 2 * mh + mm; const size_t ro = (size_t)(row0 + ai * HALF + m * 16) * 4096 + col0 + bj * HALF;
                            const f32x4 v0 = x[mm][bj][0] + gv[bj][0] * acc[ai][bj][m][0], v1 = x[mm][bj][1] + gv[bj][1] * acc[ai][bj][m][1];
                            u32x4 w; w.x = cvt_pk_bf16(v0[0], v0[1]); w.y = cvt_pk_bf16(v0[2], v0[3]); w.z = cvt_pk_bf16(v1[0], v1[1]); w.w = cvt_pk_bf16(v1[2], v1[3]);
                            *(u32x4*)(out + ro) = w; }
                }
        } else {
            bf16_t* sl = slab + (size_t)((4 * u.kt0 + 7) / nd) * 512 * 4096;
#pragma unroll
            for (int ai = 0; ai < 2; ++ai)
#pragma unroll
                for (int m = 0; m < 4; ++m) { bf16_t* orow = sl + (size_t)(row0 + ai * HALF + m * 16 - 8192) * 4096 + col0;
#pragma unroll
                    for (int bj = 0; bj < 2; ++bj) { const f32x4 v0 = acc[ai][bj][m][0], v1 = acc[ai][bj][m][1];
                        u32x4 w; w.x = cvt_pk_bf16(v0[0], v0[1]); w.y = cvt_pk_bf16(v0[2], v0[3]); w.z = cvt_pk_bf16(v1[0], v1[1]); w.w = cvt_pk_bf16(v1[2], v1[3]);
                        *(u32x4*)(orow + bj * HALF) = w; } }
        }
    }
};

template <class Epi, class Sched, bool ALIGN_EPI = false, bool SP2 = false>
__device__ __forceinline__ void gemm_phase(PG8_LAS unsigned char* lds, const Gemm g, const Sched& S, const Epi& E) {
    const int tid = threadIdx.x, wid = __builtin_amdgcn_readfirstlane(tid >> 6), lane = tid & 63, wr = wid >> 2, wc = wid & 3, fr = lane & 15, fq = lane >> 4;
    const int K = g.K;
    unsigned voffA[2], voffB[2];
#pragma unroll
    for (int i = 0; i < 2; ++i) { int R, C; stage_rc(tid * 16 + i * 8192, R, C); const int Rb = Epi::PERM ? ((R & ~31) + perm32(R & 31)) : R;
        voffA[i] = (unsigned)(R * K + C) * 2u; (void)Rb; voffB[i] = (unsigned)(tid * 16 + i * 8192); }
    const size_t kstep = (size_t)(BK * 2);
    const size_t kstepB = (size_t)HTB;
    static_assert(Epi::PERM, "the pre-tiled weight copies carry the PERM row order");
    const size_t hstep = (size_t)HALF * K * 2;
    const size_t tstep = 2 * hstep;
    const unsigned ldsw = (unsigned)wid * 1024u;
    const int aoff = lds_byte(wr * 64 + fr, fq * 8), boff = lds_byte(wc * 32 + fr, fq * 8);
#define PG8_SA(b, h) (((b) * 2 + (h)) * HTB)
#define PG8_SB(b, h) ((4 + (b) * 2 + (h)) * HTB)
#define PG8_STAGE(bufoff, gbase, voff) do { _Pragma("unroll") for (int _i = 0; _i < 2; ++_i) \
        __builtin_amdgcn_global_load_lds((const unsigned*)((const char*)(gbase) + (voff)[_i]), (PG8_LAS unsigned*)(lds + (bufoff) + ldsw + _i * 8192), 16, 0, 0); } while (0)
#define PG8_LDA(dst, b, h) do { _Pragma("unroll") for (int m = 0; m < 4; ++m) _Pragma("unroll") for (int k = 0; k < 2; ++k) dst[m][k] = *(const PG8_LAS bf16x8*)(lds + PG8_SA(b, h) + aoff + m * 2048 + k * 1024); } while (0)
#define PG8_LDB(dst, b, h) do { _Pragma("unroll") for (int n = 0; n < 2; ++n) _Pragma("unroll") for (int k = 0; k < 2; ++k) dst[n][k] = *(const PG8_LAS bf16x8*)(lds + PG8_SB(b, h) + boff + n * 2048 + k * 1024); } while (0)
#define PG8_MMA(ai, bj, At, Bt) do { __builtin_amdgcn_s_setprio(1); _Pragma("unroll") for (int m = 0; m < 4; ++m) _Pragma("unroll") for (int n = 0; n < 2; ++n) _Pragma("unroll") for (int k = 0; k < 2; ++k) \
        acc[ai][bj][m][n] = __builtin_amdgcn_mfma_f32_16x16x32_bf16(Bt[n][k], At[m][k], acc[ai][bj][m][n], 0, 0, 0); __builtin_amdgcn_s_setprio(0); } while (0)
#define PG8_WAIT_V(n) asm volatile("s_waitcnt vmcnt(" #n ")" ::: "memory")
#define PG8_WAIT_L(n) asm volatile("s_waitcnt lgkmcnt(" #n ")" ::: "memory")
#define PG8_BAR __builtin_amdgcn_s_barrier()
#define PG8_SCHED __builtin_amdgcn_sched_barrier(0)
    Unit cur, nxt; int ui = 0;
    if (!S.next(0, cur)) return;
    int nt = cur.nt;
    f32x4 acc[2][2][4][2];
#pragma unroll
    for (int a = 0; a < 2; ++a)
#pragma unroll
        for (int b = 0; b < 2; ++b)
#pragma unroll
            for (int m = 0; m < 4; ++m)
#pragma unroll
                for (int n = 0; n < 2; ++n) acc[a][b][m][n] = (f32x4){0.f, 0.f, 0.f, 0.f};
    bf16x8 At[4][2], B0[2][2], B1[2][2];
    const char* cA = (const char*)g.A + (size_t)cur.pm * tstep + (size_t)cur.kt0 * kstep; const char* cB = (const char*)g.Bt + (size_t)cur.pn * tstep + (size_t)cur.kt0 * kstepB;
    S.a_ready(cur);
    if constexpr (SP2) {
        PG8_STAGE(PG8_SB(0, 0), cB, voffB); PG8_STAGE(PG8_SB(0, 1), cB + hstep, voffB); PG8_STAGE(PG8_SA(0, 0), cA, voffA); PG8_STAGE(PG8_SA(0, 1), cA + hstep, voffA);
        if (wr == 1) PG8_BAR;
        PG8_WAIT_V(2); PG8_BAR;
        PG8_STAGE(PG8_SB(1, 0), cB + kstepB, voffB); PG8_STAGE(PG8_SA(1, 0), cA + kstep, voffA); PG8_STAGE(PG8_SB(1, 1), cB + hstep + kstepB, voffB);
        PG8_WAIT_V(6); PG8_BAR;
    } else {
        PG8_STAGE(PG8_SB(0, 0), cB, voffB); PG8_STAGE(PG8_SA(0, 0), cA, voffA); PG8_STAGE(PG8_SB(0, 1), cB + hstep, voffB); PG8_STAGE(PG8_SA(0, 1), cA + hstep, voffA);
        if (wr == 1) PG8_BAR;
        PG8_WAIT_V(4); PG8_BAR;
        PG8_STAGE(PG8_SB(1, 0), cB + kstepB, voffB); PG8_STAGE(PG8_SA(1, 0), cA + kstep, voffA); PG8_STAGE(PG8_SB(1, 1), cB + hstep + kstepB, voffB);
        PG8_WAIT_V(6); PG8_BAR;
    }
    for (;;) {
        const bool has_next = S.next(ui + 1, nxt);
        const char* nA = has_next ? (const char*)g.A + (size_t)nxt.pm * tstep + (size_t)nxt.kt0 * kstep : cA; const char* nB = has_next ? (const char*)g.Bt + (size_t)nxt.pn * tstep + (size_t)nxt.kt0 * kstepB : cB;
        for (int t = 0; t < nt; t += 2) {
            const bool last = (t == nt - 2);
            const char* a1 = cA + (size_t)(t + 1) * kstep;
            const char* a2 = last ? nA : cA + (size_t)(t + 2) * kstep; const char* b2 = last ? nB : cB + (size_t)(t + 2) * kstepB;
            const char* a3 = a2 + kstep; const char* b3 = b2 + kstepB;
            if (last && has_next) S.a_ready(nxt);
            if constexpr (SP2) {
            PG8_LDB(B0, 0, 0); PG8_LDB(B1, 0, 1); PG8_SCHED; PG8_LDA(At, 0, 0); PG8_STAGE(PG8_SA(1, 1), a1 + hstep, voffA);
            PG8_WAIT_V(8); PG8_WAIT_L(0); PG8_BAR; PG8_MMA(0, 0, At, B0); PG8_MMA(0, 1, At, B1); PG8_BAR; PG8_SCHED;
            PG8_LDA(At, 0, 1); PG8_STAGE(PG8_SB(0, 0), b2, voffB); PG8_STAGE(PG8_SB(0, 1), b2 + hstep, voffB); PG8_STAGE(PG8_SA(0, 0), a2, voffA);
            PG8_WAIT_V(8); PG8_WAIT_L(0); PG8_BAR; PG8_MMA(1, 0, At, B0); PG8_MMA(1, 1, At, B1); PG8_BAR; PG8_SCHED;
            PG8_LDB(B0, 1, 0); PG8_LDB(B1, 1, 1); PG8_SCHED; PG8_LDA(At, 1, 0); PG8_STAGE(PG8_SA(0, 1), a2 + hstep, voffA);
            PG8_WAIT_V(8); PG8_WAIT_L(0); PG8_BAR; PG8_MMA(0, 0, At, B0); PG8_MMA(0, 1, At, B1); PG8_BAR; PG8_SCHED;
            PG8_LDA(At, 1, 1); PG8_STAGE(PG8_SB(1, 0), b3, voffB); PG8_STAGE(PG8_SB(1, 1), b3 + hstep, voffB); PG8_STAGE(PG8_SA(1, 0), a3, voffA);
            PG8_WAIT_V(8); PG8_WAIT_L(0); PG8_BAR; PG8_MMA(1, 0, At, B0); PG8_MMA(1, 1, At, B1); PG8_BAR; PG8_SCHED;
            } else {
            PG8_LDB(B0, 0, 0); PG8_SCHED; PG8_LDA(At, 0, 0); PG8_STAGE(PG8_SA(1, 1), a1 + hstep, voffA);
            PG8_WAIT_L(8); PG8_BAR; PG8_WAIT_L(0); PG8_MMA(0, 0, At, B0); PG8_BAR; PG8_SCHED;
            PG8_LDB(B1, 0, 1); PG8_STAGE(PG8_SB(0, 0), b2, voffB);
            PG8_BAR; PG8_WAIT_L(0); PG8_MMA(0, 1, At, B1); PG8_BAR;
            PG8_LDA(At, 0, 1); PG8_STAGE(PG8_SA(0, 0), a2, voffA);
            PG8_BAR; PG8_WAIT_L(0); PG8_MMA(1, 0, At, B0); PG8_BAR; PG8_SCHED;
            PG8_STAGE(PG8_SB(0, 1), b2 + hstep, voffB);
            PG8_WAIT_V(6); PG8_BAR; PG8_MMA(1, 1, At, B1); PG8_BAR;
            PG8_LDB(B0, 1, 0); PG8_SCHED; PG8_LDA(At, 1, 0); PG8_STAGE(PG8_SA(0, 1), a2 + hstep, voffA);
            PG8_WAIT_L(8); PG8_BAR; PG8_WAIT_L(0); PG8_MMA(0, 0, At, B0); PG8_BAR; PG8_SCHED;
            PG8_LDB(B1, 1, 1); PG8_STAGE(PG8_SB(1, 0), b3, voffB);
            PG8_BAR; PG8_WAIT_L(0); PG8_MMA(0, 1, At, B1); PG8_BAR;
            PG8_LDA(At, 1, 1); PG8_STAGE(PG8_SA(1, 0), a3, voffA);
            PG8_BAR; PG8_WAIT_L(0); PG8_MMA(1, 0, At, B0); PG8_BAR; PG8_SCHED;
            PG8_STAGE(PG8_SB(1, 1), b3 + hstep, voffB);
            PG8_WAIT_V(6); PG8_BAR; PG8_MMA(1, 1, At, B1); PG8_BAR;
            }
        }
        if constexpr (ALIGN_EPI) { if (wr == 0) PG8_BAR; }
        if constexpr (!Epi::AFTER_DRAIN) { E(acc, cur, wr, wc, fr, fq); S.done(cur); }
        if (!has_next) break;
#pragma unroll
        for (int a = 0; a < 2; ++a)
#pragma unroll
            for (int b = 0; b < 2; ++b)
#pragma unroll
                for (int m = 0; m < 4; ++m)
#pragma unroll
                    for (int n = 0; n < 2; ++n) acc[a][b][m][n] = (f32x4){0.f, 0.f, 0.f, 0.f};
        cur = nxt; cA = nA; cB = nB; ++ui; nt = cur.nt;
        if constexpr (ALIGN_EPI) { if (wr == 1) PG8_BAR; }
    }
    PG8_WAIT_V(0);
    if constexpr (!ALIGN_EPI) { if (wr == 0) PG8_BAR; }
    PG8_BAR;
    if constexpr (Epi::AFTER_DRAIN) { E.fused(acc, cur, wr, wc, fr, fq, lds, wid, lane); S.done(cur); }
#undef PG8_SA
#undef PG8_SB
#undef PG8_STAGE
#undef PG8_LDA
#undef PG8_LDB
#undef PG8_MMA
#undef PG8_WAIT_V
#undef PG8_WAIT_L
#undef PG8_BAR
#undef PG8_SCHED
}
}

constexpr int NWAVES = 8;
constexpr int D = 4096, TP = 8192, TS = 512, MROWS = TP + TS, DB = 128, DSQ = 4;
constexpr int NIN = 9232, NINP = 9472, F2 = 22016, FF = 11008, NMOD = 24576;
constexpr int PC_GQ = 0, PC_GK = 1024, PC_GV = 2048, PC_GR = 4096, PC_SQ = 6144, PC_SK = 8192, PC_SV = 8704, PC_GA = 9216;
constexpr float NORM_EPS = 1e-6f;
constexpr size_t MiB = 1u << 20;
constexpr size_t WS_CTL = 0, CTL_ZERO_BYTES = 65536;
constexpr size_t WS_CS = 1 * MiB;
constexpr size_t WS_MOD = 3 * MiB;
constexpr size_t WS_WIN = 27 * MiB;
constexpr size_t WS_WO = 101 * MiB;
constexpr size_t WS_WUP = 133 * MiB;
constexpr size_t WS_WDN = 305 * MiB;
constexpr size_t WS_X1 = 391 * MiB;
constexpr size_t WS_X2 = 459 * MiB;
constexpr size_t WS_H = 527 * MiB;
constexpr size_t WS_MIX = 595 * MiB;
constexpr size_t WS_BIG = 663 * MiB;
constexpr size_t WS_WADA = WS_BIG;
constexpr size_t WS_PROJ = 855 * MiB;
constexpr size_t WS_CHK = 1013 * MiB;
constexpr size_t WS_VTF = 1046 * MiB;
constexpr size_t WS_OIA = 1078 * MiB;
constexpr size_t WS_SPF = 1142 * MiB;
constexpr size_t WS_UE = WS_BIG;
constexpr size_t WS_US = 760 * MiB;
constexpr size_t WS_G = 1029 * MiB;
constexpr size_t WS_SLAB = 1212 * MiB;
constexpr size_t WS_END = 1276 * MiB;
static_assert(WS_UE + (size_t)2048 * F2 * 2 <= WS_US && WS_US + (size_t)TS * F2 * 2 <= WS_G && WS_G + (size_t)MROWS * FF * 2 <= WS_SLAB && WS_PROJ + (size_t)MROWS * NINP * 2 <= WS_CHK && WS_CHK + 512 * 66560 <= WS_VTF && WS_VTF + 32 * MiB <= WS_OIA && WS_WADA + (size_t)NMOD * D * 2 <= WS_PROJ, "ws map");
constexpr int I_O_P0 = 1024;
constexpr int CW_WORK = 64, CW_WORK4 = 128, CW_WORK5 = 192;
constexpr int CW_BAR = 4096;
constexpr size_t O_Y = 0, O_GLA_P = 35651584, O_K_P = 36175872, O_V_P = 36241408, O_CONV_P = 36306944, O_GLA_S = 36350976, O_K_S = 103459840, O_V_S = 111848448, O_CONV_S = 120237056, O_END = 125873152;
constexpr int LDS_BYTES = 147456, LDS_SCR = 1024;

#define GAS __attribute__((address_space(1)))
#define LAS __attribute__((address_space(3)))
#define DI __device__ __forceinline__
typedef unsigned short bf16;
typedef unsigned u32x4 __attribute__((ext_vector_type(4)));
typedef unsigned u32x2 __attribute__((ext_vector_type(2)));
typedef float f32x4 __attribute__((ext_vector_type(4)));
typedef short bf16x8 __attribute__((ext_vector_type(8)));
typedef short bf16x4 __attribute__((ext_vector_type(4)));
#define LDS_WAIT() asm volatile("s_waitcnt lgkmcnt(0)" ::: "memory")
#define VM_WAIT() asm volatile("s_waitcnt vmcnt(0)" ::: "memory")
#define MFMA16(a, b, c) __builtin_amdgcn_mfma_f32_16x16x32_bf16((a), (b), (c), 0, 0, 0)
DI int opq(int x) { asm volatile("" : "+v"(x)); return x; }
DI float bf2f(unsigned v) { return __uint_as_float(v << 16); }
DI float bflo(unsigned w) { return __uint_as_float(w << 16); }
DI float bfhi(unsigned w) { return __uint_as_float(w & 0xffff0000u); }
DI unsigned pkbf(float lo, float hi) { return pg8::cvt_pk_bf16(lo, hi); }
DI float wave_sum(float v) {
#pragma unroll
    for (int o = 1; o < 64; o <<= 1) v += __shfl_xor(v, o);
    return v;
}
DI float silu_f(float x) { return x / (1.0f + __expf(-x)); }
DI float logsig16(float z) { return (fminf(z, 0.0f) - __logf(1.0f + __expf(-fabsf(z)))) * 0.0625f; }
#define XB_TMO      128
#define XB_XCNT(j)  (256  + 64 * (j))
#define XB_XSUB(j)  (1280 + 64 * (j))
#define XB_XGEN(j)  (2304 + 64 * (j))
#define XB_TOP      3328
#define XB_TOPGEN   3392
#define XCD_BAR_WORDS 3456
#define XB_SPIN_CAP (1u << 18)

__device__ __forceinline__ unsigned xb_ld(unsigned* p)              { return __hip_atomic_load(p, __ATOMIC_RELAXED, __HIP_MEMORY_SCOPE_AGENT); }
__device__ __forceinline__ unsigned xb_add(unsigned* p, unsigned v) { return __hip_atomic_fetch_add(p, v, __ATOMIC_RELAXED, __HIP_MEMORY_SCOPE_AGENT); }
__device__ __forceinline__ unsigned xb_xcc_id() { return (unsigned)__builtin_amdgcn_s_getreg((3 << 11) | 20) & 0xFu; }
#define XB_SPIN(cond, bar) do { unsigned _sp = 0; while (cond) { __builtin_amdgcn_s_sleep(1); \
    if ((++_sp & 255u) == 0u) { if (xb_ld(&(bar)[XB_TMO])) break; if (_sp > XB_SPIN_CAP) { atomicAdd(&(bar)[XB_TMO], 1u); break; } } } } while (0)

struct XcdBarrier {
    unsigned* bar; unsigned x;
    volatile LAS unsigned* st;
};

__device__ __forceinline__ XcdBarrier xcd_barrier_post(unsigned* bar, volatile LAS unsigned* st) {
    XcdBarrier b; b.bar = bar; b.x = xb_xcc_id(); b.st = st;
    if (threadIdx.x == 0) (void)xb_add(&bar[XB_XCNT(b.x)], 1u);
    return b;
}
__device__ __forceinline__ void xcd_barrier_complete(unsigned* bar, unsigned x, unsigned& nloc, unsigned& nx) {
    const unsigned G = gridDim.x * gridDim.y * gridDim.z;
    unsigned sum, cnt, mine, sp = 0u;
    for (;;) {
        sum = 0u; cnt = 0u; mine = 0u;
#pragma unroll
        for (unsigned j = 0; j < 16; ++j) { const unsigned c = xb_ld(&bar[XB_XCNT(j)]); sum += c; cnt += (c > 0u) ? 1u : 0u; mine = (j == x) ? c : mine; }
        if (sum == G) break;
        __builtin_amdgcn_s_sleep(1);
        if ((++sp & 255u) == 0u) { if (xb_ld(&bar[XB_TMO])) break; if (sp > XB_SPIN_CAP) { atomicAdd(&bar[XB_TMO], 1u); break; } }
    }
    nloc = mine > 0u ? mine : 1u; nx = cnt > 0u ? cnt : 1u;
}

__device__ __forceinline__ void xcd_barrier(const XcdBarrier& b) {
    asm volatile("s_waitcnt vmcnt(0)" ::: "memory");
    __syncthreads();
    if (threadIdx.x == 0) {
        unsigned* bar = b.bar;
        __builtin_amdgcn_s_waitcnt(0);
        unsigned nloc = b.st[0], nx = b.st[1];
        if (nloc == 0u) { xcd_barrier_complete(bar, b.x, nloc, nx); b.st[0] = nloc; b.st[1] = nx; }
        const unsigned old = xb_add(&bar[XB_XSUB(b.x)], 1u);
        const unsigned gen = old / nloc;
        if (old + 1u == (gen + 1u) * nloc) {
            __builtin_amdgcn_fence(__ATOMIC_RELEASE, "agent");
            asm volatile("s_waitcnt vmcnt(0)" ::: "memory");
            const unsigned og = xb_add(&bar[XB_TOP], 1u);
            const unsigned tg = og / nx;
            if (og + 1u == (tg + 1u) * nx) xb_add(&bar[XB_TOPGEN], 1u);
            else XB_SPIN(xb_ld(&bar[XB_TOPGEN]) == tg, bar);
            __builtin_amdgcn_fence(__ATOMIC_ACQUIRE, "agent");
            xb_add(&bar[XB_XGEN(b.x)], 1u);
            asm volatile("s_waitcnt vmcnt(0)" ::: "memory");
        } else {
            XB_SPIN(xb_ld(&bar[XB_XGEN(b.x)]) == gen, bar);
            __builtin_amdgcn_fence(__ATOMIC_ACQUIRE, "agent");
            asm volatile("s_waitcnt vmcnt(0)" ::: "memory");
        }
    }
    __syncthreads();
}

struct Args { const float* in[22]; float* out; unsigned char* ws; int ph_lo, ph_hi, li, pad; };
enum { I_XP = 0, I_XS, I_CP, I_CS, I_SGLA, I_SK, I_SV, I_SCONV, I_WADA, I_BADA, I_GNORM, I_WIN, I_WAUP, I_BA, I_GGLA, I_SINK, I_WO, I_WUP, I_WCONV, I_BCONV, I_WDN, I_GFIN };

DI size_t wt_off(int nrow, int K, int k) {
    const int nl = nrow & 127, c = nl & 31, rho = 16 * ((c >> 2) & 1) + 4 * (c >> 3) + (c & 3);
    return ((size_t)(nrow >> 7) * (K >> 6) + (k >> 6)) * 16384 + pg8::lds_byte((nl & ~31) + rho, k & 63);
}
DI void tr_item(const float* __restrict__ W, int ldw, int k0, int nsrc0, int nvalid, bf16* __restrict__ WT, int ldt, int ndst0, LAS unsigned char* scr, int lane) {
    const int rg = lane >> 4, c4 = lane & 15;
    f32x4 v[4][4];
    const bool ok = (4 * c4) < nvalid;
#pragma unroll
    for (int kq = 0; kq < 4; ++kq)
#pragma unroll
        for (int j = 0; j < 4; ++j) {
            if (ok) v[kq][j] = *(const f32x4*)(W + (size_t)(k0 + 16 * kq + 4 * rg + j) * ldw + nsrc0 + 4 * c4);
            else v[kq][j] = (f32x4){0.f, 0.f, 0.f, 0.f};
        }
    const int x = 2 * (c4 & 7);
#pragma unroll
    for (int kq = 0; kq < 4; ++kq)
#pragma unroll
        for (int jn = 0; jn < 4; ++jn) {
            u32x2 w; w.x = pkbf(v[kq][0][jn], v[kq][1][jn]); w.y = pkbf(v[kq][2][jn], v[kq][3][jn]);
            const int g = 4 * kq + rg, n = 4 * c4 + jn;
            *(LAS u32x2*)(scr + n * 128 + ((g ^ x) * 8)) = w;
        }
    LDS_WAIT();
#pragma unroll
    for (int i = 0; i < 8; ++i) {
        const int n = (lane >> 3) + 8 * i, kc = lane & 7, xx = 2 * ((n >> 2) & 7);
        const u32x4 w = *(const LAS u32x4*)(scr + n * 128 + (((2 * kc) ^ xx) * 8));
        *(u32x4*)((unsigned char*)WT + wt_off(ndst0 + n, ldt, k0 + 8 * kc)) = w;
    }
    LDS_WAIT();
}
DI void tr_load(f32x4 (&v)[4][4], const float* __restrict__ W, int ldw, int k0, int nsrc0, int lane) {
    const int rg = lane >> 4, c4 = lane & 15;
#pragma unroll
    for (int kq = 0; kq < 4; ++kq)
#pragma unroll
        for (int j = 0; j < 4; ++j) v[kq][j] = *(const f32x4*)(W + (size_t)(k0 + 16 * kq + 4 * rg + j) * ldw + nsrc0 + 4 * c4);
}
DI void tr_emit(const f32x4 (&v)[4][4], bf16* __restrict__ WT, int ldt, int k0, int ndst0, LAS unsigned char* scr, int lane) {
    const int rg = lane >> 4, c4 = lane & 15, x = 2 * (c4 & 7);
#pragma unroll
    for (int kq = 0; kq < 4; ++kq)
#pragma unroll
        for (int jn = 0; jn < 4; ++jn) {
            u32x2 w; w.x = pkbf(v[kq][0][jn], v[kq][1][jn]); w.y = pkbf(v[kq][2][jn], v[kq][3][jn]);
            const int g = 4 * kq + rg, n = 4 * c4 + jn;
            *(LAS u32x2*)(scr + n * 128 + ((g ^ x) * 8)) = w;
        }
    LDS_WAIT();
#pragma unroll
    for (int i = 0; i < 8; ++i) {
        const int n = (lane >> 3) + 8 * i, kc = lane & 7, xx = 2 * ((n >> 2) & 7);
        const u32x4 w = *(const LAS u32x4*)(scr + n * 128 + (((2 * kc) ^ xx) * 8));
        *(u32x4*)((unsigned char*)WT + wt_off(ndst0 + n, ldt, k0 + 8 * kc)) = w;
    }
    LDS_WAIT();
}
DI void tr_plain2(const float* W, int K, int N, bf16* WT, int itA, int itB, LAS unsigned char* scr, int lane) {
    const int nb = N / 64, kA = itA / nb, nA = itA % nb, kB = itB / nb, nB = itB % nb;
    f32x4 va[4][4], vb[4][4];
    tr_load(va, W, N, 64 * kA, 64 * nA, lane); tr_load(vb, W, N, 64 * kB, 64 * nB, lane);
    tr_emit(va, WT, K, 64 * kA, 64 * nA, scr, lane); tr_emit(vb, WT, K, 64 * kB, 64 * nB, scr, lane);
}
DI void tr_wup2(const float* W, bf16* WT, int itA, int itB, LAS unsigned char* scr, int lane) {
    constexpr int nb = F2 / 64;
    const int kA = itA / nb, dA = itA % nb, kB = itB / nb, dB = itB % nb;
    const int sA = 64 * ((dA & 2) ? FF / 64 + 2 * (dA >> 2) + (dA & 1) : 2 * (dA >> 2) + (dA & 1)), sB = 64 * ((dB & 2) ? FF / 64 + 2 * (dB >> 2) + (dB & 1) : 2 * (dB >> 2) + (dB & 1));
    f32x4 va[4][4], vb[4][4];
    tr_load(va, W, F2, 64 * kA, sA, lane); tr_load(vb, W, F2, 64 * kB, sB, lane);
    tr_emit(va, WT, D, 64 * kA, 64 * dA, scr, lane); tr_emit(vb, WT, D, 64 * kB, 64 * dB, scr, lane);
}
DI void tr_plain(const float* W, int K, int N, bf16* WT, int it, LAS unsigned char* scr, int lane) {
    const int nb = N / 64, kb = it / nb, n = it % nb;
    tr_item(W, N, 64 * kb, 64 * n, 64, WT, K, 64 * n, scr, lane);
}
DI void tr_win(const float* W, bf16* WT, int it, LAS unsigned char* scr, int lane) {
    constexpr int nb = NINP / 64;
    const int kb = it / nb, n = it % nb;
    int nsrc0, nvalid;
    if (n < 96) { nsrc0 = 64 * n; nvalid = 64; }
    else if (n < 144) { nsrc0 = 64 * n + 16; nvalid = 64; }
    else if (n == 144) { nsrc0 = 6144; nvalid = 16; }
    else { nsrc0 = 0; nvalid = 0; }
    tr_item(W, NIN, 64 * kb, nsrc0, nvalid, WT, D, 64 * n, scr, lane);
}

constexpr int AD_CS_PITCH = 144, AD_CS_BYTES = 144 * AD_CS_PITCH, AD_IMG = 2 * AD_CS_BYTES, AD_IMG_PITCH = 144, AD_IMG_BYTES = 16 * AD_IMG_PITCH;
DI void adaln_block(int item0, const float* c_sample, const float* c_prompt, const float* W, const float* bias, float* MOD, LAS unsigned char* scr, int tid) {
    const int wave = tid >> 6, lane = tid & 63, l15 = lane & 15, quad = lane >> 4;
    const int n0 = 16 * (item0 + wave);
    LAS unsigned char* img = scr + AD_IMG + wave * AD_IMG_BYTES;
    for (int i = tid; i < 2 * 15 * (AD_CS_PITCH / 16); i += 512) { const int b = i / (15 * (AD_CS_PITCH / 16)), j = i % (15 * (AD_CS_PITCH / 16));
        *(LAS u32x4*)(scr + b * AD_CS_BYTES + 129 * AD_CS_PITCH + j * 16) = (u32x4){0u, 0u, 0u, 0u}; }
    f32x4 acc[9];
#pragma unroll
    for (int m = 0; m < 9; ++m) acc[m] = (f32x4){0.f, 0.f, 0.f, 0.f};
    const int rg = lane >> 2, c4 = lane & 3;
    const float* wp = W + (size_t)(4 * rg) * NMOD + n0 + 4 * c4;
    f32x4 wa[4], wb[4];
#pragma unroll
    for (int j = 0; j < 4; ++j) { wa[j] = __builtin_nontemporal_load((const f32x4*)(wp + (size_t)j * NMOD)); wb[j] = __builtin_nontemporal_load((const f32x4*)(wp + (size_t)(64 + j) * NMOD)); }
    f32x4 cv[5];
#define AD_CLOAD(s) do { _Pragma("unroll") for (int t = 0; t < 5; ++t) { int i = tid + 512 * t; i = i < 129 * 16 ? i : 129 * 16 - 1; const int m = i >> 4, q = i & 15; \
        cv[t] = *(const f32x4*)((m < 128 ? c_sample + (size_t)m * D : c_prompt) + 64 * (s) + 4 * q); } } while (0)
#define AD_CSTORE(buf) do { _Pragma("unroll") for (int t = 0; t < 5; ++t) { const int i = tid + 512 * t; const int m = i >> 4, q = i & 15; \
        u32x2 w; w.x = pkbf(silu_f(cv[t].x), silu_f(cv[t].y)); w.y = pkbf(silu_f(cv[t].z), silu_f(cv[t].w)); \
        if (i < 129 * 16) *(LAS u32x2*)((buf) + m * AD_CS_PITCH + q * 8) = w; } } while (0)
    AD_CLOAD(0); AD_CSTORE(scr);
    __syncthreads();
#define AD_STEP(wc, kblk) do { \
        const LAS unsigned char* abuf = scr + ((kblk) & 1) * AD_CS_BYTES; \
        { const int sn = (kblk) + 1 < 64 ? (kblk) + 1 : 63; AD_CLOAD(sn); }     \
        _Pragma("unroll") for (int jn = 0; jn < 4; ++jn) { u32x2 w; w.x = pkbf(wc[0][jn], wc[1][jn]); w.y = pkbf(wc[2][jn], wc[3][jn]); *(LAS u32x2*)(img + (4 * c4 + jn) * AD_IMG_PITCH + rg * 8) = w; } \
        { const int kn = (kblk) + 2 < 64 ? (kblk) + 2 : 63;                    \
          _Pragma("unroll") for (int j = 0; j < 4; ++j) wc[j] = __builtin_nontemporal_load((const f32x4*)(wp + (size_t)(64 * kn + j) * NMOD)); } \
        bf16x8 af[18];                                                         \
        _Pragma("unroll") for (int m = 0; m < 9; ++m) { const LAS unsigned char* ap = abuf + (16 * m + l15) * AD_CS_PITCH + (8 * quad) * 2; af[2 * m] = *(const LAS bf16x8*)ap; af[2 * m + 1] = *(const LAS bf16x8*)(ap + 64); } \
        const bf16x8 b0 = *(const LAS bf16x8*)(img + l15 * AD_IMG_PITCH + (8 * quad) * 2), b1 = *(const LAS bf16x8*)(img + l15 * AD_IMG_PITCH + (32 + 8 * quad) * 2); \
        __builtin_amdgcn_sched_barrier(0); \
        _Pragma("unroll") for (int m = 0; m < 9; ++m) acc[m] = MFMA16(af[2 * m], b0, acc[m]); \
        _Pragma("unroll") for (int m = 0; m < 9; ++m) acc[m] = MFMA16(af[2 * m + 1], b1, acc[m]); \
        __builtin_amdgcn_sched_barrier(0); \
        AD_CSTORE(scr + (((kblk) + 1) & 1) * AD_CS_BYTES);                     \
        __syncthreads(); } while (0)
#pragma unroll 1
    for (int kb2 = 0; kb2 < 64; kb2 += 2) { AD_STEP(wa, kb2); AD_STEP(wb, kb2 + 1); }
#undef AD_STEP
#undef AD_CLOAD
#undef AD_CSTORE
    const float bv = bias[n0 + l15];
#pragma unroll
    for (int m = 0; m < 9; ++m)
#pragma unroll
        for (int r = 0; r < 4; ++r) { const int row = 16 * m + 4 * quad + r; if (row <= 128) MOD[(size_t)row * NMOD + n0 + l15] = acc[m][r] + bv; }
    __syncthreads();
}

DI f32x4 ld4(const float* p) { return *(const f32x4*)p; }
DI f32x4 ld4(const bf16* p) { const u32x2 w = *(const u32x2*)p; return (f32x4){bflo(w.x), bfhi(w.x), bflo(w.y), bfhi(w.y)}; }
template <int MODE, class T>
DI void sample_pair(int pr, const T* base, const float* MOD, int gate_off, const bf16* SLAB, bf16* xout, const float* g, int sc_off, int sh_off, bf16* Hs, float* outY, LAS float* red, int tid) {
    constexpr bool SLABS = MODE != 0, FINAL = MODE == 2;
    const int wave = tid >> 6, lane = tid & 63, r = 2 * pr + (wave >> 2), c0 = 1024 * (wave & 3) + 4 * lane;
    const float* m = MOD + (size_t)(r >> 2) * NMOD;
    const size_t ro = (size_t)r * D;
    f32x4 s[4], xb[4], gt[4];
#pragma unroll
    for (int j = 0; j < 4; ++j) { const int c = c0 + 256 * j; xb[j] = ld4(base + ro + c); if (SLABS) { s[j] = ld4(SLAB + ro + c); gt[j] = *(const f32x4*)(m + gate_off + c); } }
#pragma unroll
    for (int ks = 1; ks < (SLABS ? 8 : 1); ++ks)
#pragma unroll
        for (int j = 0; j < 4; ++j) s[j] += ld4(SLAB + (size_t)ks * 512 * 4096 + ro + c0 + 256 * j);
    float ss = 0.f;
#pragma unroll
    for (int j = 0; j < 4; ++j) {
        f32x4 v = xb[j];
        if (SLABS) v += gt[j] * s[j];
        if (MODE == 1) { u32x2 w; w.x = pkbf(v.x, v.y); w.y = pkbf(v.z, v.w); *(u32x2*)(xout + ro + c0 + 256 * j) = w; v = (f32x4){bflo(w.x), bfhi(w.x), bflo(w.y), bfhi(w.y)}; }
        s[j] = v; ss += (v.x * v.x + v.y * v.y) + (v.z * v.z + v.w * v.w);
    }
    ss = wave_sum(ss);
    if (lane == 0) red[wave] = ss;
    __syncthreads();
    const int w4 = wave & ~3;
    const float rstd = 1.0f / sqrtf(((red[w4] + red[w4 + 1]) + (red[w4 + 2] + red[w4 + 3])) * (1.0f / D) + NORM_EPS);
#pragma unroll
    for (int j = 0; j < 4; ++j) { const int c = c0 + 256 * j;
        if (FINAL) *(f32x4*)(outY + ro + c) = (s[j] * rstd) * *(const f32x4*)(g + c);
        else { const f32x4 o = (s[j] * rstd) * *(const f32x4*)(g + c) * (*(const f32x4*)(m + sc_off + c) + 1.0f) + *(const f32x4*)(m + sh_off + c);
            u32x2 w; w.x = pkbf(o.x, o.y); w.y = pkbf(o.z, o.w); *(u32x2*)(Hs + ro + c) = w; }
    }
    __syncthreads();
}
DI void modnorm_row(const float* xrow, const float* g, const float* sc, const float* sh, bf16* orow, int lane) {
    f32x4 v[16]; float s = 0.f;
#pragma unroll
    for (int j = 0; j < 16; ++j) { v[j] = *(const f32x4*)(xrow + 4 * (lane + 64 * j)); s += (v[j].x * v[j].x + v[j].y * v[j].y) + (v[j].z * v[j].z + v[j].w * v[j].w); }
    const float rstd = 1.0f / sqrtf(wave_sum(s) * (1.0f / D) + NORM_EPS);
#pragma unroll
    for (int j = 0; j < 16; ++j) {
        const int c = 4 * (lane + 64 * j);
        const f32x4 gv = *(const f32x4*)(g + c), sv = *(const f32x4*)(sc + c), hv = *(const f32x4*)(sh + c);
        const f32x4 o = (v[j] * rstd) * gv * (sv + 1.0f) + hv;
        u32x2 w; w.x = pkbf(o.x, o.y); w.y = pkbf(o.z, o.w);
        *(u32x2*)(orow + c) = w;
    }
}
DI void load_row_bf(f32x4 (&v)[16], const bf16* xrow, int lane) {
#pragma unroll
    for (int j = 0; j < 8; ++j) { const u32x4 w = *(const u32x4*)(xrow + 8 * (lane + 64 * j));
        v[2 * j] = (f32x4){bflo(w.x), bfhi(w.x), bflo(w.y), bfhi(w.y)}; v[2 * j + 1] = (f32x4){bflo(w.z), bfhi(w.z), bflo(w.w), bfhi(w.w)}; }
}
DI void modnorm_row(const bf16* xrow, const float* g, const float* sc, const float* sh, bf16* orow, int lane) {
    f32x4 v[16]; float s = 0.f;
    load_row_bf(v, xrow, lane);
#pragma unroll
    for (int j = 0; j < 16; ++j) s += (v[j].x * v[j].x + v[j].y * v[j].y) + (v[j].z * v[j].z + v[j].w * v[j].w);
    const float rstd = 1.0f / sqrtf(wave_sum(s) * (1.0f / D) + NORM_EPS);
#pragma unroll
    for (int j = 0; j < 8; ++j) {
        const int c = 8 * (lane + 64 * j);
        u32x4 w; unsigned* wp = (unsigned*)&w;
#pragma unroll
        for (int hh = 0; hh < 2; ++hh) {
            const f32x4 gv = *(const f32x4*)(g + c + 4 * hh), sv = *(const f32x4*)(sc + c + 4 * hh), hv = *(const f32x4*)(sh + c + 4 * hh);
            const f32x4 o = (v[2 * j + hh] * rstd) * gv * (sv + 1.0f) + hv;
            wp[2 * hh] = pkbf(o.x, o.y); wp[2 * hh + 1] = pkbf(o.z, o.w);
        }
        *(u32x4*)(orow + c) = w;
    }
}
DI void finalnorm_row(const bf16* xrow, float* orow, const float* g, int lane) {
    f32x4 v[16]; float s = 0.f;
    load_row_bf(v, xrow, lane);
#pragma unroll
    for (int j = 0; j < 16; ++j) s += (v[j].x * v[j].x + v[j].y * v[j].y) + (v[j].z * v[j].z + v[j].w * v[j].w);
    const float rstd = 1.0f / sqrtf(wave_sum(s) * (1.0f / D) + NORM_EPS);
#pragma unroll
    for (int j = 0; j < 8; ++j) { const int c = 8 * (lane + 64 * j);
        *(f32x4*)(orow + c) = (v[2 * j] * rstd) * *(const f32x4*)(g + c); *(f32x4*)(orow + c + 4) = (v[2 * j + 1] * rstd) * *(const f32x4*)(g + c + 4); }
}

constexpr int KS_PITCH = 272, VT_PITCH = 528, SWA_KS_OFF = 0, SWA_VT_OFF = 256 * KS_PITCH;
template <int NDM>
DI void swa_group(const LAS unsigned char* Ks, const LAS unsigned char* Vt, const bf16* qptr, int ts, int ie, int kmin, float slope, float sink, int dbase, bf16* optr, int lane) {
    const int l15 = lane & 15, quad = lane >> 4;
    bf16x8 bq[4];
#pragma unroll
    for (int s = 0; s < 4; ++s) bq[s] = *(const bf16x8*)(qptr + 32 * s + 8 * quad);
    f32x4 sc[10];
#pragma unroll
    for (int kt = 0; kt < 10; ++kt) sc[kt] = (f32x4){0.f, 0.f, 0.f, 0.f};
#define SW_SB() __builtin_amdgcn_sched_barrier(0)
#define SW_LK(f, p) do { _Pragma("unroll") for (int i = 0; i < 8; ++i) f[i] = *(const LAS bf16x8*)(Ks + (16 * (ts + 2 * (p) + (i >> 2)) + l15) * KS_PITCH + (32 * (i & 3) + 8 * quad) * 2); } while (0)
#define SW_MK(f, p) do { _Pragma("unroll") for (int i = 0; i < 8; ++i) sc[2 * (p) + (i >> 2)] = MFMA16(f[i], bq[i & 3], sc[2 * (p) + (i >> 2)]); } while (0)
    {
        bf16x8 ka[8], kb[8];
        SW_LK(ka, 0); SW_LK(kb, 1);
        SW_SB(); SW_MK(ka, 0); SW_SB(); SW_LK(ka, 2);
        SW_SB(); SW_MK(kb, 1); SW_SB(); SW_LK(kb, 3);
        SW_SB(); SW_MK(ka, 2); SW_SB(); SW_LK(ka, 4);
        SW_SB(); SW_MK(kb, 3);
        SW_SB(); SW_MK(ka, 4); SW_SB();
    }
    float mx = sink;
#pragma unroll
    for (int kt = 0; kt < 10; ++kt)
#pragma unroll
        for (int r = 0; r < 4; ++r) {
            const int key = 16 * (ts + kt) + 4 * quad + r, dd = 128 + ie - key;
            const bool valid = (dd >= 0) && (dd <= 128) && (key >= kmin);
            const float sv = valid ? (sc[kt][r] * 0.08838834764831845f - slope * (float)dd) : -1e30f;
            sc[kt][r] = sv; mx = fmaxf(mx, sv);
        }
    mx = fmaxf(mx, __shfl_xor(mx, 16)); mx = fmaxf(mx, __shfl_xor(mx, 32));
    float sum = 0.f;
#pragma unroll
    for (int kt = 0; kt < 10; ++kt)
#pragma unroll
        for (int r = 0; r < 4; ++r) { const float p = __expf(sc[kt][r] - mx); sc[kt][r] = p; sum += p; }
    sum += __shfl_xor(sum, 16); sum += __shfl_xor(sum, 32);
    sum += __expf(sink - mx);
    const float inv = 1.0f / sum;
    f32x4 o[NDM];
#pragma unroll
    for (int dm = 0; dm < NDM; ++dm) o[dm] = (f32x4){0.f, 0.f, 0.f, 0.f};
#define SW_LV(f, st) do { _Pragma("unroll") for (int dm = 0; dm < NDM; ++dm) { const LAS unsigned char* vp = Vt + (dbase + 16 * dm + l15) * VT_PITCH + (16 * (ts + 2 * (st)) + 4 * quad) * 2; \
        const bf16x4 lo = *(const LAS bf16x4*)vp, hi = *(const LAS bf16x4*)(vp + 32); f[dm] = __builtin_shufflevector(lo, hi, 0, 1, 2, 3, 4, 5, 6, 7); } } while (0)
#define SW_MV(f, st) do { u32x4 pw; pw.x = pkbf(sc[2 * (st)][0], sc[2 * (st)][1]); pw.y = pkbf(sc[2 * (st)][2], sc[2 * (st)][3]); pw.z = pkbf(sc[2 * (st) + 1][0], sc[2 * (st) + 1][1]); pw.w = pkbf(sc[2 * (st) + 1][2], sc[2 * (st) + 1][3]); \
        const bf16x8 bp = __builtin_bit_cast(bf16x8, pw); _Pragma("unroll") for (int dm = 0; dm < NDM; ++dm) o[dm] = MFMA16(f[dm], bp, o[dm]); } while (0)
    {
        bf16x8 va[NDM], vb[NDM];
        SW_LV(va, 0); SW_LV(vb, 1);
        SW_SB(); SW_MV(va, 0); SW_SB(); SW_LV(va, 2);
        SW_SB(); SW_MV(vb, 1); SW_SB(); SW_LV(vb, 3);
        SW_SB(); SW_MV(va, 2); SW_SB(); SW_LV(va, 4);
        SW_SB(); SW_MV(vb, 3);
        SW_SB(); SW_MV(va, 4); SW_SB();
    }
#undef SW_SB
#undef SW_LK
#undef SW_MK
#undef SW_LV
#undef SW_MV
#pragma unroll
    for (int dm = 0; dm < NDM; ++dm) {
        u32x2 w; w.x = pkbf(o[dm][0] * inv, o[dm][1] * inv); w.y = pkbf(o[dm][2] * inv, o[dm][3] * inv);
        *(u32x2*)(optr + 16 * dm + 4 * quad) = w;
    }
}
DI float alibi_slope(int head) { return exp2f(-0.5f * (float)(head + 1)); }
DI f32x4 bf4lo(const u32x4 w) { return (f32x4){bflo(w.x), bfhi(w.x), bflo(w.y), bfhi(w.y)}; }
DI f32x4 bf4hi(const u32x4 w) { return (f32x4){bflo(w.z), bfhi(w.z), bflo(w.w), bfhi(w.w)}; }
DI void vt_store(LAS unsigned char* Vt, int c, int j0, const u32x4 w0, const u32x4 w1) {
    LAS unsigned char* vb = Vt + (8 * c) * VT_PITCH + j0 * 2;
    *(LAS unsigned*)(vb + 0 * VT_PITCH) = (w0.x & 0xffffu) | (w1.x << 16);
    *(LAS unsigned*)(vb + 1 * VT_PITCH) = (w0.x >> 16) | (w1.x & 0xffff0000u);
    *(LAS unsigned*)(vb + 2 * VT_PITCH) = (w0.y & 0xffffu) | (w1.y << 16);
    *(LAS unsigned*)(vb + 3 * VT_PITCH) = (w0.y >> 16) | (w1.y & 0xffff0000u);
    *(LAS unsigned*)(vb + 4 * VT_PITCH) = (w0.z & 0xffffu) | (w1.z << 16);
    *(LAS unsigned*)(vb + 5 * VT_PITCH) = (w0.z >> 16) | (w1.z & 0xffff0000u);
    *(LAS unsigned*)(vb + 6 * VT_PITCH) = (w0.w & 0xffffu) | (w1.w << 16);
    *(LAS unsigned*)(vb + 7 * VT_PITCH) = (w0.w >> 16) | (w1.w & 0xffff0000u);
}

DI void swa_prompt_unit(int qb, int kvh, const bf16* PROJ, const float* sinks, bf16* MIX, float* outK, float* outV, LAS unsigned char* scr, int tid) {
    LAS unsigned char* Ks = scr + SWA_KS_OFF; LAS unsigned char* Vt = scr + SWA_VT_OFF;
    const int pos_base = 128 * (qb - 1);
    {
        u32x4 kw[8];
#pragma unroll
        for (int it = 0; it < 8; ++it) {
            const int ch = tid + 512 * it, j = ch >> 4, c = ch & 15, pos = pos_base + j;
            kw[it] = (u32x4){0u, 0u, 0u, 0u};
            if (pos >= 0) kw[it] = *(const u32x4*)(PROJ + (size_t)pos * NINP + PC_SK + kvh * 128 + 8 * c);
        }
#pragma unroll
        for (int it = 0; it < 8; ++it) { const int ch = tid + 512 * it; *(LAS u32x4*)(Ks + (ch >> 4) * KS_PITCH + (ch & 15) * 16) = kw[it]; }
    }
    {
        u32x4 vw[8];
#pragma unroll
        for (int it = 0; it < 4; ++it) {
            const int jp = tid & 127, c = (tid >> 7) + 4 * it, pos0 = pos_base + 2 * jp;
            vw[2 * it] = (u32x4){0u, 0u, 0u, 0u}; vw[2 * it + 1] = vw[2 * it];
            if (pos0 >= 0) { const bf16* p = PROJ + (size_t)pos0 * NINP + PC_SV + kvh * 128 + 8 * c; vw[2 * it] = *(const u32x4*)p; vw[2 * it + 1] = *(const u32x4*)(p + NINP); }
        }
#pragma unroll
        for (int it = 0; it < 4; ++it) vt_store(Vt, (tid >> 7) + 4 * it, 2 * (tid & 127), vw[2 * it], vw[2 * it + 1]);
    }
    if (qb == 63) {
#pragma unroll 1
        for (int ch = tid; ch < 2 * 128 * 16; ch += 512) {
            const int kv = ch >> 11, j = (ch >> 4) & 127, c = ch & 15;
            const u32x4 w = *(const u32x4*)(PROJ + (size_t)(TP - 128 + j) * NINP + (kv ? PC_SV : PC_SK) + kvh * 128 + 8 * c);
            float* o = (kv ? outV : outK) + (size_t)j * 512 + kvh * 128 + 8 * c; *(f32x4*)o = bf4lo(w); *(f32x4*)(o + 4) = bf4hi(w);
        }
    }
    __syncthreads();
    const int wave = tid >> 6, lane = tid & 63, l15 = lane & 15;
    const int g = wave >> 1, head = kvh * 4 + g;
    const float slope = alibi_slope(head), sink = sinks[head];
#pragma unroll 1
    for (int q4 = 0; q4 < 4; ++q4) {
        const int i0 = 64 * (wave & 1) + 16 * q4, ts = (i0 >> 4) < 6 ? (i0 >> 4) : 6;
        const size_t row = (size_t)128 * qb + i0 + l15;
        swa_group<8>(Ks, Vt, PROJ + row * NINP + PC_SQ + head * 128, ts, i0 + l15, qb == 0 ? 128 : 0, slope, sink, 0, MIX + row * D + 2048 + head * 128, lane);
    }
    __syncthreads();
}
DI void swa_sample_unit(int b, int kvh, const bf16* PROJ, const float* stK, const float* stV, const float* sinks, bf16* MIX, float* outK, float* outV, LAS unsigned char* scr, int tid) {
    LAS unsigned char* Ks = scr + SWA_KS_OFF; LAS unsigned char* Vt = scr + SWA_VT_OFF;
    const size_t sbase = (size_t)b * 128 * 512 + kvh * 128;
    const size_t prow = (size_t)(TP + 4 * b);
    {
        f32x4 ka[4], kb[4];
#pragma unroll
        for (int it = 0; it < 4; ++it) { const int ch = tid + 512 * it; const float* p = stK + sbase + (size_t)(ch >> 4) * 512 + 8 * (ch & 15); ka[it] = __builtin_nontemporal_load((const f32x4*)p); kb[it] = __builtin_nontemporal_load((const f32x4*)(p + 4)); }
        f32x4 va[2][4];
#pragma unroll
        for (int it = 0; it < 2; ++it) { const int jp = tid & 63, c = (tid >> 6) + 8 * it; const float* p = stV + sbase + (size_t)(2 * jp) * 512 + 8 * c;
            va[it][0] = __builtin_nontemporal_load((const f32x4*)p); va[it][1] = __builtin_nontemporal_load((const f32x4*)(p + 4)); va[it][2] = __builtin_nontemporal_load((const f32x4*)(p + 512)); va[it][3] = __builtin_nontemporal_load((const f32x4*)(p + 516)); }
#pragma unroll
        for (int it = 0; it < 4; ++it) {
            const int ch = tid + 512 * it, j = ch >> 4, c = ch & 15;
            u32x4 w; w.x = pkbf(ka[it].x, ka[it].y); w.y = pkbf(ka[it].z, ka[it].w); w.z = pkbf(kb[it].x, kb[it].y); w.w = pkbf(kb[it].z, kb[it].w);
            *(LAS u32x4*)(Ks + j * KS_PITCH + c * 16) = w;
            if (j >= 4) { float* o = outK + sbase + (size_t)(j - 4) * 512 + 8 * c; *(f32x4*)o = ka[it]; *(f32x4*)(o + 4) = kb[it]; }
        }
#pragma unroll
        for (int it = 0; it < 2; ++it) {
            const int jp = tid & 63, c = (tid >> 6) + 8 * it, j0 = 2 * jp;
            u32x4 w0, w1;
            w0.x = pkbf(va[it][0].x, va[it][0].y); w0.y = pkbf(va[it][0].z, va[it][0].w); w0.z = pkbf(va[it][1].x, va[it][1].y); w0.w = pkbf(va[it][1].z, va[it][1].w);
            w1.x = pkbf(va[it][2].x, va[it][2].y); w1.y = pkbf(va[it][2].z, va[it][2].w); w1.z = pkbf(va[it][3].x, va[it][3].y); w1.w = pkbf(va[it][3].z, va[it][3].w);
            vt_store(Vt, c, j0, w0, w1);
            if (j0 >= 4) { float* o = outV + sbase + (size_t)(j0 - 4) * 512 + 8 * c; *(f32x4*)o = va[it][0]; *(f32x4*)(o + 4) = va[it][1]; *(f32x4*)(o + 512) = va[it][2]; *(f32x4*)(o + 516) = va[it][3]; }
        }
    }
    {
        const int j = 128 + (tid >> 4), c = tid & 15;
        u32x4 w = (u32x4){0u, 0u, 0u, 0u};
        if (j < 132) {
            w = *(const u32x4*)(PROJ + (prow + (j - 128)) * NINP + PC_SK + kvh * 128 + 8 * c);
            float* o = outK + sbase + (size_t)(j - 4) * 512 + 8 * c; *(f32x4*)o = bf4lo(w); *(f32x4*)(o + 4) = bf4hi(w);
        }
        *(LAS u32x4*)(Ks + j * KS_PITCH + c * 16) = w;
        if (tid < 256) {
            const int jp = 64 + (tid & 15), cv = tid >> 4, j0 = 2 * jp;
            u32x4 w0 = (u32x4){0u, 0u, 0u, 0u}, w1 = w0;
            if (j0 < 132) {
                const bf16* p = PROJ + (prow + (j0 - 128)) * NINP + PC_SV + kvh * 128 + 8 * cv; w0 = *(const u32x4*)p; w1 = *(const u32x4*)(p + NINP);
                float* o = outV + sbase + (size_t)(j0 - 4) * 512 + 8 * cv;
                *(f32x4*)o = bf4lo(w0); *(f32x4*)(o + 4) = bf4hi(w0); *(f32x4*)(o + 512) = bf4lo(w1); *(f32x4*)(o + 516) = bf4hi(w1);
            }
            vt_store(Vt, cv, j0, w0, w1);
        }
    }
    __syncthreads();
    const int wave = tid >> 6, lane = tid & 63, l15 = lane & 15;
    const int g = l15 >> 2, t = l15 & 3, head = kvh * 4 + g;
    const size_t row = prow + t;
    swa_group<1>(Ks, Vt, PROJ + row * NINP + PC_SQ + head * 128, 0, t, 0, alibi_slope(head), sinks[head], 16 * wave, MIX + row * D + 2048 + head * 128 + 16 * wave, lane);
    __syncthreads();
}

constexpr int CHK_BYTES = 66560;
constexpr int GL_GA = 0, GL_PART = 4096, GL_QG = 6144, GL_KG = 6144 + 33792, GL_VTF = 6144 + 2 * 33792, GL_AM = GL_QG, GL_PITCH = 528, AM_PITCH = 144;
DI void gla_local_unit(int n, int h, const bf16* PROJ, const float* w_a_up, const float* b_a, unsigned char* CHK, unsigned char* VTF, bf16* OIA, LAS unsigned char* scr, int tid, int stop) {
    const size_t row0 = (size_t)64 * n, hn = (size_t)h * 128 + n;
    const int wave = tid >> 6, lane = tid & 63, l15 = lane & 15, quad = lane >> 4;
    LAS float* gaS = (LAS float*)(scr + GL_GA); LAS float* partS = (LAS float*)(scr + GL_PART);
    LAS float* ZS = (LAS float*)(scr + GL_VTF);
    for (int idx = tid; idx < 1024; idx += 512) gaS[idx] = bf2f(PROJ[(row0 + (idx >> 4)) * NINP + PC_GA + (idx & 15)]);
    u32x4 wv[8];
    {
        const bf16* vp = PROJ + row0 * NINP + PC_GV + h * 512 + tid;
#pragma unroll
        for (int g8 = 0; g8 < 8; ++g8) {
            unsigned e[8];
#pragma unroll
            for (int j = 0; j < 8; ++j) e[j] = vp[(size_t)(8 * g8 + j) * NINP];
            wv[g8].x = e[0] | (e[1] << 16); wv[g8].y = e[2] | (e[3] << 16); wv[g8].z = e[4] | (e[5] << 16); wv[g8].w = e[6] | (e[7] << 16);
        }
    }
    float wb[2][4];
#pragma unroll
    for (int nt = 0; nt < 2; ++nt)
#pragma unroll
        for (int s = 0; s < 4; ++s) wb[nt][s] = w_a_up[(4 * s + quad) * 1024 + h * 256 + 32 * wave + 16 * nt + l15];
    const float bz0 = b_a[h * 256 + 32 * wave + l15], bz1 = b_a[h * 256 + 32 * wave + 16 + l15];
    __syncthreads();
    if (stop == 1) return;
#pragma unroll
    for (int mt = 0; mt < 4; ++mt) {
        f32x4 z0 = (f32x4){bz0, bz0, bz0, bz0}, z1 = (f32x4){bz1, bz1, bz1, bz1};
#pragma unroll
        for (int s = 0; s < 4; ++s) { const float a = gaS[(16 * mt + l15) * 16 + 4 * s + quad];
            z0 = __builtin_amdgcn_mfma_f32_16x16x4f32(a, wb[0][s], z0, 0, 0, 0); z1 = __builtin_amdgcn_mfma_f32_16x16x4f32(a, wb[1][s], z1, 0, 0, 0); }
#pragma unroll
        for (int r = 0; r < 4; ++r) { ZS[(16 * mt + 4 * quad + r) * 256 + 32 * wave + l15] = z0[r]; ZS[(16 * mt + 4 * quad + r) * 256 + 32 * wave + 16 + l15] = z1[r]; }
    }
    __syncthreads();
    const int k = tid & 255, half = tid >> 8, col = h * 256 + k;
    {
        float s = 0.f;
#pragma unroll 8
        for (int t = 32 * half; t < 32 * half + 32; ++t) { const float la = logsig16(ZS[t * 256 + k]); ZS[t * 256 + k] = la; s += la; }
        partS[half * 256 + k] = s;
    }
    __syncthreads();
    if (stop == 2) return;
    {
        const float p0 = partS[k], p1 = partS[256 + k], blast = p0 + p1;
        float bc = half ? p0 : 0.f;
        const float dec = __expf(blast);
        if (half == 0) *(float*)(CHK + hn * CHK_BYTES + 65536 + k * 4) = dec;
        const bf16* qp = PROJ + (row0 + 32 * half) * NINP + PC_GQ + col; const bf16* kp = PROJ + (row0 + 32 * half) * NINP + PC_GK + col;
        unsigned qk[32];
#pragma unroll
        for (int t = 0; t < 32; ++t) qk[t] = (unsigned)qp[(size_t)t * NINP] | ((unsigned)kp[(size_t)t * NINP] << 16);
        u32x4 kdw[4];
#pragma unroll
        for (int q4 = 0; q4 < 4; ++q4) {
            float kd[8];
#pragma unroll
            for (int j = 0; j < 8; ++j) {
                const int t = 32 * half + 8 * q4 + j;
                bc += ZS[t * 256 + k];
                const float qv = bflo(qk[8 * q4 + j]) * 0.0625f, kv = bfhi(qk[8 * q4 + j]);
                const float eb = __expf(bc), qg = qv * eb, kg = kv * __builtin_amdgcn_rcpf(eb);
                kd[j] = kg * dec;
                *(LAS bf16*)(scr + GL_QG + t * GL_PITCH + k * 2) = (bf16)(pkbf(qg, 0.f) & 0xffffu);
                *(LAS bf16*)(scr + GL_KG + t * GL_PITCH + k * 2) = (bf16)(pkbf(kg, 0.f) & 0xffffu);
            }
            kdw[q4].x = pkbf(kd[0], kd[1]); kdw[q4].y = pkbf(kd[2], kd[3]); kdw[q4].z = pkbf(kd[4], kd[5]); kdw[q4].w = pkbf(kd[6], kd[7]);
        }
#pragma unroll
        for (int q4 = 0; q4 < 4; ++q4) {
            const int off = ((((k >> 4) * 2 + half) * 64) + q4 * 16 + (k & 15)) * 16;
            *(u32x4*)(CHK + hn * CHK_BYTES + 32768 + off) = kdw[q4];
        }
    }
    __syncthreads();
    if (stop == 3) return;
#pragma unroll
    for (int g8 = 0; g8 < 8; ++g8) {
        const int off = ((((tid >> 4) * 2 + (g8 >> 2)) * 64) + (g8 & 3) * 16 + (tid & 15)) * 16;
        *(LAS u32x4*)(scr + GL_VTF + off) = wv[g8];
        *(u32x4*)(VTF + hn * 65536 + off) = wv[g8];
    }
#pragma unroll
    for (int i = 0; i < 4; ++i) {
        const int f = tid + 512 * i, frag = f >> 6, ln = f & 63, fl = ln & 15, fq = ln >> 4, mt = frag >> 3, st = frag & 7, t = 16 * mt + fl;
        const u32x2 lo = *(const LAS u32x2*)(scr + GL_QG + t * GL_PITCH + (32 * st + 4 * fq) * 2), hi = *(const LAS u32x2*)(scr + GL_QG + t * GL_PITCH + (32 * st + 16 + 4 * fq) * 2);
        *(u32x4*)(CHK + hn * CHK_BYTES + (size_t)f * 16) = (u32x4){lo.x, lo.y, hi.x, hi.y};
    }
    f32x4 a0 = (f32x4){0.f, 0.f, 0.f, 0.f}, a1 = a0;
    const int mt = wave >> 1, nt0 = 2 * (wave & 1);
#pragma unroll
    for (int st = 0; st < 8; ++st) {
        const bf16x8 a = *(const LAS bf16x8*)(scr + GL_QG + (16 * mt + l15) * GL_PITCH + (32 * st + 8 * quad) * 2);
        const bf16x8 b0 = *(const LAS bf16x8*)(scr + GL_KG + (16 * nt0 + l15) * GL_PITCH + (32 * st + 8 * quad) * 2);
        const bf16x8 b1 = *(const LAS bf16x8*)(scr + GL_KG + (16 * (nt0 + 1) + l15) * GL_PITCH + (32 * st + 8 * quad) * 2);
        a0 = MFMA16(a, b0, a0); a1 = MFMA16(a, b1, a1);
    }
    __syncthreads();
    if (stop == 4) return;
#pragma unroll
    for (int r = 0; r < 4; ++r) {
        const int t = 16 * mt + 4 * quad + r, s0 = 16 * nt0 + l15, s1 = s0 + 16;
        *(LAS bf16*)(scr + GL_AM + t * AM_PITCH + s0 * 2) = (bf16)(pkbf(s0 <= t ? a0[r] : 0.f, 0.f) & 0xffffu);
        *(LAS bf16*)(scr + GL_AM + t * AM_PITCH + s1 * 2) = (bf16)(pkbf(s1 <= t ? a1[r] : 0.f, 0.f) & 0xffffu);
    }
    __syncthreads();
    for (int vti = 0; vti < 4; ++vti) {
        const int vt = 4 * wave + vti;
        const bf16x8 b0 = *(const LAS bf16x8*)(scr + GL_VTF + ((vt * 2 + 0) * 64 + lane) * 16), b1 = *(const LAS bf16x8*)(scr + GL_VTF + ((vt * 2 + 1) * 64 + lane) * 16);
#pragma unroll
        for (int m2 = 0; m2 < 4; ++m2) {
            const bf16x8 x0 = *(const LAS bf16x8*)(scr + GL_AM + (16 * m2 + l15) * AM_PITCH + (8 * quad) * 2), x1 = *(const LAS bf16x8*)(scr + GL_AM + (16 * m2 + l15) * AM_PITCH + (32 + 8 * quad) * 2);
            f32x4 acc = (f32x4){0.f, 0.f, 0.f, 0.f};
            acc = MFMA16(b0, x0, acc); acc = MFMA16(b1, x1, acc);
            u32x2 w; w.x = pkbf(acc[0], acc[1]); w.y = pkbf(acc[2], acc[3]);
            *(u32x2*)(OIA + (row0 + 16 * m2 + l15) * 2048 + h * 512 + 16 * vt + 4 * quad) = w;
        }
    }
    __syncthreads();
}

constexpr int SC_KD = 0, SC_DEC = 32768, SC_VT = 33792, SC_BUF = 35840;
constexpr int SC_NP = SC_BUF / 16, SC_NC = (32768 + 1024) / 16;
DI u32x4 gload16(const unsigned char* p) { u32x4 r; asm volatile("global_load_dwordx4 %0, %1, off" : "=v"(r) : "v"(p) : "memory"); return r; }
DI void scan_issue(u32x4 (&r)[5], const unsigned char* CHK, const unsigned char* VTF, size_t hn, int c, int lt) {
    const unsigned char* a = CHK + hn * CHK_BYTES + 32768; const unsigned char* b = VTF + hn * 65536 + 2048 * c - (size_t)SC_NC * 16;
#pragma unroll
    for (int i = 0; i < 5; ++i) { const int p = lt + 448 * i; r[i] = gload16((p < SC_NC ? a : b) + (size_t)p * 16); }
}
#define SCAN_WAIT(r, N) asm volatile("s_waitcnt vmcnt(" #N ")" : "+v"(r[0]), "+v"(r[1]), "+v"(r[2]), "+v"(r[3]), "+v"(r[4]) :: "memory")
DI void scan_commit(const u32x4 (&r)[5], LAS unsigned char* buf, int lt) {
#pragma unroll
    for (int i = 0; i < 5; ++i) *(LAS u32x4*)(buf + (lt + 448 * i) * 16) = r[i];
}
DI void gla_scan_block(int h, int c, const unsigned char* CHK, const unsigned char* VTF, unsigned char* SPF, float* outS, LAS unsigned char* scr, int tid) {
    const int wave = tid >> 6, lane = tid & 63, l15 = lane & 15, quad = lane >> 4;
    LAS unsigned char* buf0 = scr; LAS unsigned char* buf1 = scr + SC_BUF;
    const size_t hn0 = (size_t)h * 128;
    if (wave >= 1) {
        const int lt = tid - 64;
        u32x4 r0[5], r1[5], r2[5], r3[5];
        scan_issue(r0, CHK, VTF, hn0, c, lt); SCAN_WAIT(r0, 0); scan_commit(r0, buf0, lt);
        scan_issue(r0, CHK, VTF, hn0 + 1, c, lt); scan_issue(r1, CHK, VTF, hn0 + 2, c, lt); scan_issue(r2, CHK, VTF, hn0 + 3, c, lt); scan_issue(r3, CHK, VTF, hn0 + 4, c, lt);
        __syncthreads();
#define SCAN_STEP(r, buf, nn) do { SCAN_WAIT(r, 15); scan_commit(r, buf, lt); { const int n5 = (nn) < 128 ? (nn) : 127; scan_issue(r, CHK, VTF, hn0 + n5, c, lt); } __syncthreads(); } while (0)
        for (int n = 0; n < 128; n += 4) {
            SCAN_STEP(r0, buf1, n + 5);
            SCAN_STEP(r1, buf0, n + 6);
            SCAN_STEP(r2, buf1, n + 7);
            SCAN_STEP(r3, buf0, n + 8);
        }
#undef SCAN_STEP
        SCAN_WAIT(r0, 0); SCAN_WAIT(r1, 0); SCAN_WAIT(r2, 0); SCAN_WAIT(r3, 0);
    } else {
        f32x4 S[16];
#pragma unroll
        for (int kt = 0; kt < 16; ++kt) S[kt] = (f32x4){0.f, 0.f, 0.f, 0.f};
        __syncthreads();
        unsigned char* sp_out = SPF + ((hn0 * 32 + c) * 8) * 1024 + lane * 16;
        for (int n = 0; n < 128; ++n) {
            const LAS unsigned char* buf = (n & 1) ? buf1 : buf0;
#define SC_SB() __builtin_amdgcn_sched_barrier(0)
#define SC_LK(f, dcv, q) do { _Pragma("unroll") for (int i = 0; i < 8; ++i) f[i] = *(const LAS bf16x8*)(buf + SC_KD + ((8 * (q) + i) * 64 + lane) * 16); \
        _Pragma("unroll") for (int i = 0; i < 4; ++i) dcv[i] = *(const LAS f32x4*)(buf + SC_DEC + (16 * (4 * (q) + i) + 4 * quad) * 4); } while (0)
#define SC_MU(f, dcv, q) do { _Pragma("unroll") for (int i = 0; i < 4; ++i) S[4 * (q) + i] = MFMA16(f[2 * i], v0, S[4 * (q) + i] * dcv[i]); \
        _Pragma("unroll") for (int i = 0; i < 4; ++i) S[4 * (q) + i] = MFMA16(f[2 * i + 1], v1, S[4 * (q) + i]); } while (0)
            bf16x8 fa[8], fb[8]; f32x4 da[4], db[4];
            SC_LK(fa, da, 0); SC_LK(fb, db, 1);
            const bf16x8 v0 = *(const LAS bf16x8*)(buf + SC_VT + lane * 16), v1 = *(const LAS bf16x8*)(buf + SC_VT + (64 + lane) * 16);
#pragma unroll
            for (int st = 0; st < 8; ++st) {
                u32x4 pw; pw.x = pkbf(S[2 * st][0], S[2 * st][1]); pw.y = pkbf(S[2 * st][2], S[2 * st][3]); pw.z = pkbf(S[2 * st + 1][0], S[2 * st + 1][1]); pw.w = pkbf(S[2 * st + 1][2], S[2 * st + 1][3]);
                *(u32x4*)(sp_out + (size_t)n * (32 * 8 * 1024) + st * 1024) = pw;
            }
            SC_SB(); SC_MU(fa, da, 0); SC_SB(); SC_LK(fa, da, 2);
            SC_SB(); SC_MU(fb, db, 1); SC_SB(); SC_LK(fb, db, 3);
            SC_SB(); SC_MU(fa, da, 2);
            SC_SB(); SC_MU(fb, db, 3);
#undef SC_SB
#undef SC_LK
#undef SC_MU
            __syncthreads();
        }
        float* sp = outS + (size_t)h * 256 * 512 + 16 * c + l15;
#pragma unroll
        for (int kt = 0; kt < 16; ++kt)
#pragma unroll
            for (int r = 0; r < 4; ++r) sp[(size_t)(16 * kt + 4 * quad + r) * 512] = S[kt][r];
    }
}

DI void gla_sample_unit(int b, int h, const bf16* PROJ, const float* w_a_up, const float* b_a, const float* g_gla, const float* st0, float* stN, bf16* MIX, LAS unsigned char* scr, int tid) {
    LAS float* qgS = (LAS float*)scr; LAS float* kgS = qgS + 1024; LAS float* kdS = kgS + 1024; LAS float* decS = kdS + 1024; LAS float* vS = decS + 256;
    LAS float* AS = vS + 2048; LAS float* part = AS + 64; LAS float* red = part + 8192;
    const size_t row0 = (size_t)TP + 4 * b;
    const int grp = tid >> 7, c = tid & 127;
    const size_t sb = ((size_t)(b * 4 + h) * 256 + 64 * grp) * 512 + 4 * c;
    f32x4 sA[16], sB[16];
#pragma unroll
    for (int i = 0; i < 16; ++i) sA[i] = __builtin_nontemporal_load((const f32x4*)(st0 + sb + (size_t)i * 512));
    if (tid < 256) {
        const int k = tid, col = h * 256 + k;
        float z[4];
#pragma unroll
        for (int t = 0; t < 4; ++t) z[t] = b_a[col];
#pragma unroll
        for (int r = 0; r < 16; ++r) { const float w = w_a_up[r * 1024 + col];
#pragma unroll
            for (int t = 0; t < 4; ++t) z[t] += bf2f(PROJ[(row0 + t) * NINP + PC_GA + r]) * w; }
        float bt[4], bs = 0.f;
#pragma unroll
        for (int t = 0; t < 4; ++t) { bs += logsig16(z[t]); bt[t] = bs; }
#pragma unroll
        for (int t = 0; t < 4; ++t) {
            const float qv = bf2f(PROJ[(row0 + t) * NINP + PC_GQ + col]) * 0.0625f, kv = bf2f(PROJ[(row0 + t) * NINP + PC_GK + col]);
            qgS[t * 256 + k] = qv * __expf(bt[t]); kgS[t * 256 + k] = kv * __expf(-bt[t]); kdS[t * 256 + k] = kv * __expf(bs - bt[t]);
        }
        decS[k] = __expf(bs);
    } else {
        const int tt = tid - 256;
#pragma unroll
        for (int i = 0; i < 8; ++i) { const int idx = tt + 256 * i; vS[idx] = bf2f(PROJ[(row0 + (idx >> 9)) * NINP + PC_GV + h * 512 + (idx & 511)]); }
    }
    __syncthreads();
    const int wave = tid >> 6, lane = tid & 63;
    for (int p = wave; p < 10; p += 8) {
        const int t = (p >= 6) ? 3 : (p >= 3) ? 2 : (p >= 1) ? 1 : 0, s = p - (t * (t + 1)) / 2;
        float a = 0.f;
#pragma unroll
        for (int i = 0; i < 4; ++i) a += qgS[t * 256 + lane + 64 * i] * kgS[s * 256 + lane + 64 * i];
        a = wave_sum(a);
        if (lane == 0) AS[t * 4 + s] = a;
    }
    __syncthreads();
    f32x4 vv[4], oa[4];
#pragma unroll
    for (int t = 0; t < 4; ++t) { vv[t] = *(const LAS f32x4*)(vS + t * 512 + 4 * c); oa[t] = (f32x4){0.f, 0.f, 0.f, 0.f}; }
#define GS_LOAD(buf, k0) do { _Pragma("unroll") for (int i = 0; i < 16; ++i) buf[i] = __builtin_nontemporal_load((const f32x4*)(st0 + sb + (size_t)((k0) + i) * 512)); } while (0)
#define GS_STEP(buf, k0) do { _Pragma("unroll") for (int i = 0; i < 16; ++i) { const int k = 64 * grp + (k0) + i; f32x4 sn = buf[i] * decS[k]; \
        _Pragma("unroll") for (int t = 0; t < 4; ++t) { sn += vv[t] * kdS[t * 256 + k]; oa[t] += buf[i] * qgS[t * 256 + k]; } \
        __builtin_nontemporal_store(sn, (f32x4*)(stN + sb + (size_t)((k0) + i) * 512)); } } while (0)
    GS_LOAD(sB, 16); GS_STEP(sA, 0);
    GS_LOAD(sA, 32); GS_STEP(sB, 16);
    GS_LOAD(sB, 48); GS_STEP(sA, 32);
    GS_STEP(sB, 48);
#undef GS_LOAD
#undef GS_STEP
#pragma unroll
    for (int t = 0; t < 4; ++t) *(LAS f32x4*)(part + (grp * 4 + t) * 512 + 4 * c) = oa[t];
    __syncthreads();
    {
        const int t = tid >> 7;
        f32x4 o = (f32x4){0.f, 0.f, 0.f, 0.f};
#pragma unroll
        for (int g = 0; g < 4; ++g) o += *(const LAS f32x4*)(part + (g * 4 + t) * 512 + 4 * c);
        for (int s = 0; s <= t; ++s) o += *(const LAS f32x4*)(vS + s * 512 + 4 * c) * AS[t * 4 + s];
        float ss = wave_sum((o.x * o.x + o.y * o.y) + (o.z * o.z + o.w * o.w));
        if (lane == 0) red[wave] = ss;
        __syncthreads();
        const float rstd = 1.0f / sqrtf((red[2 * t] + red[2 * t + 1]) * (1.0f / 512.0f) + NORM_EPS);
        const f32x4 gg = *(const f32x4*)(g_gla + 4 * c);
        const u32x2 gr = *(const u32x2*)(PROJ + (row0 + t) * NINP + PC_GR + h * 512 + 4 * c);
        const f32x4 r4 = (f32x4){silu_f(bflo(gr.x)), silu_f(bfhi(gr.x)), silu_f(bflo(gr.y)), silu_f(bfhi(gr.y))};
        const f32x4 y = (o * rstd) * gg * r4;
        u32x2 w; w.x = pkbf(y.x, y.y); w.y = pkbf(y.z, y.w);
        *(u32x2*)(MIX + (row0 + t) * D + h * 512 + 4 * c) = w;
    }
    __syncthreads();
}

DI void gla_out_unit(int n, int h, const unsigned char* CHK, const unsigned char* SPF, const bf16* OIA, const bf16* PROJ, const float* g_gla, bf16* MIX, LAS unsigned char* scr, int tid) {
    const int wave = tid >> 6, lane = tid & 63, l15 = lane & 15, quad = lane >> 4;
    const size_t hn = (size_t)h * 128 + n, row0 = (size_t)64 * n;
    LAS float* red = (LAS float*)(scr + 32768);
    bf16x8 af[4][4], ag[4][4];
    const unsigned char* sp = SPF + ((hn * 32 + 4 * wave) * 8) * 1024 + lane * 16;
#pragma unroll
    for (int vt = 0; vt < 4; ++vt)
#pragma unroll
        for (int st = 0; st < 4; ++st) { af[vt][st] = *(const bf16x8*)(sp + (vt * 8 + st) * 1024); ag[vt][st] = *(const bf16x8*)(sp + (vt * 8 + 4 + st) * 1024); }
#pragma unroll
    for (int i = 0; i < 4; ++i) { const int p = tid + 512 * i; *(LAS u32x4*)(scr + p * 16) = *(const u32x4*)(CHK + hn * CHK_BYTES + (size_t)p * 16); }
    __syncthreads();
    f32x4 acc[4][4];
#pragma unroll
    for (int vt = 0; vt < 4; ++vt)
#pragma unroll
        for (int mt = 0; mt < 4; ++mt) acc[vt][mt] = (f32x4){0.f, 0.f, 0.f, 0.f};
#pragma unroll
    for (int st = 0; st < 8; ++st) {
        bf16x8 bq[4];
#pragma unroll
        for (int mt = 0; mt < 4; ++mt) bq[mt] = *(const LAS bf16x8*)(scr + ((mt * 8 + st) * 64 + lane) * 16);
#pragma unroll
        for (int vt = 0; vt < 4; ++vt)
#pragma unroll
            for (int mt = 0; mt < 4; ++mt) acc[vt][mt] = MFMA16(st < 4 ? af[vt][st & 3] : ag[vt][st & 3], bq[mt], acc[vt][mt]);
    }
    float ss[4];
#pragma unroll
    for (int mt = 0; mt < 4; ++mt) {
        const bf16* op = OIA + (row0 + 16 * mt + l15) * 2048 + h * 512 + 64 * wave + 4 * quad;
        float s = 0.f;
#pragma unroll
        for (int vt = 0; vt < 4; ++vt) { acc[vt][mt] += ld4(op + 16 * vt); const f32x4 o = acc[vt][mt]; s += (o.x * o.x + o.y * o.y) + (o.z * o.z + o.w * o.w); }
        s += __shfl_xor(s, 16); s += __shfl_xor(s, 32);
        ss[mt] = s;
        if (quad == 0) red[wave * 64 + 16 * mt + l15] = s;
    }
    __syncthreads();
#pragma unroll
    for (int mt = 0; mt < 4; ++mt) {
        float tot = 0.f;
#pragma unroll
        for (int w = 0; w < 8; ++w) tot += red[w * 64 + 16 * mt + l15];
        const float rstd = 1.0f / sqrtf(tot * (1.0f / 512.0f) + NORM_EPS);
        const size_t row = row0 + 16 * mt + l15;
#pragma unroll
        for (int vt = 0; vt < 4; ++vt) {
            const int col = h * 512 + 64 * wave + 16 * vt + 4 * quad;
            const f32x4 gg = *(const f32x4*)(g_gla + 64 * wave + 16 * vt + 4 * quad);
            const u32x2 gr = *(const u32x2*)(PROJ + row * NINP + PC_GR + col);
            const f32x4 r4 = (f32x4){silu_f(bflo(gr.x)), silu_f(bfhi(gr.x)), silu_f(bflo(gr.y)), silu_f(bfhi(gr.y))};
            const f32x4 y = (acc[vt][mt] * rstd) * gg * r4;
            u32x2 w; w.x = pkbf(y.x, y.y); w.y = pkbf(y.z, y.w);
            *(u32x2*)(MIX + row * D + col) = w;
        }
    }
    (void)ss;
    __syncthreads();
}

DI void stagger_start(int bid, unsigned ticks) {
    const unsigned long long t0 = __builtin_amdgcn_s_memrealtime(), dly = (unsigned long long)((bid >> 3) & 31) * ticks;
    while (__builtin_amdgcn_s_memrealtime() - t0 < dly) __builtin_amdgcn_s_sleep(2);
}

struct CRow { f32x4 g[2], v[2]; };
DI CRow crow_bf16i(const bf16* p) { const u32x4 a = *(const u32x4*)p, c = *(const u32x4*)(p + 128); CRow r;
    r.g[0] = (f32x4){bflo(a.x), bfhi(a.x), bflo(a.y), bfhi(a.y)}; r.g[1] = (f32x4){bflo(a.z), bfhi(a.z), bflo(a.w), bfhi(a.w)};
    r.v[0] = (f32x4){bflo(c.x), bfhi(c.x), bflo(c.y), bfhi(c.y)}; r.v[1] = (f32x4){bflo(c.z), bfhi(c.z), bflo(c.w), bfhi(c.w)}; return r; }
DI CRow crow_f32(const float* p) { CRow r; r.g[0] = *(const f32x4*)p; r.g[1] = *(const f32x4*)(p + 4); r.v[0] = *(const f32x4*)(p + FF); r.v[1] = *(const f32x4*)(p + FF + 4); return r; }
DI CRow crow_zero() { CRow r; r.g[0] = r.g[1] = r.v[0] = r.v[1] = (f32x4){0.f, 0.f, 0.f, 0.f}; return r; }
struct CTaps { f32x4 wg[3][2], wv[3][2], bg[2], bv[2]; };
DI CTaps ctaps_load(const float* wc, const float* bc, int f) { CTaps t;
#pragma unroll
    for (int hh = 0; hh < 2; ++hh) {
#pragma unroll
        for (int j = 0; j < 3; ++j) { t.wg[j][hh] = *(const f32x4*)(wc + (size_t)j * F2 + f + 4 * hh); t.wv[j][hh] = *(const f32x4*)(wc + (size_t)j * F2 + FF + f + 4 * hh); }
        t.bg[hh] = *(const f32x4*)(bc + f + 4 * hh); t.bv[hh] = *(const f32x4*)(bc + FF + f + 4 * hh);
    }
    return t; }
DI float silu_r(float x) { return x * __builtin_amdgcn_rcpf(1.0f + __expf(-x)); }
DI void conv_half(const CTaps& t, int hh, const f32x4& p2g, const f32x4& p1g, const f32x4& cg, const f32x4& p2v, const f32x4& p1v, const f32x4& cv, unsigned& w0, unsigned& w1) {
    const f32x4 g = t.bg[hh] + t.wg[0][hh] * p2g + t.wg[1][hh] * p1g + t.wg[2][hh] * cg;
    const f32x4 v = t.bv[hh] + t.wv[0][hh] * p2v + t.wv[1][hh] * p1v + t.wv[2][hh] * cv;
    w0 = pkbf(silu_r(g.x) * v.x, silu_r(g.y) * v.y); w1 = pkbf(silu_r(g.z) * v.z, silu_r(g.w) * v.w);
}
DI u32x4 conv_out(const CTaps& t, const CRow& p2, const CRow& p1, const CRow& c) { u32x4 w; unsigned* wp = (unsigned*)&w;
#pragma unroll
    for (int hh = 0; hh < 2; ++hh) conv_half(t, hh, p2.g[hh], p1.g[hh], c.g[hh], p2.v[hh], p1.v[hh], c.v[hh], wp[2 * hh], wp[2 * hh + 1]);
    return w; }
DI float dpp_shr1(float x) { return __builtin_bit_cast(float, __builtin_amdgcn_update_dpp(0, __builtin_bit_cast(int, x), 0x111, 0xf, 0xf, true)); }
DI float dpp_shr2(float x) { return __builtin_bit_cast(float, __builtin_amdgcn_update_dpp(0, __builtin_bit_cast(int, x), 0x112, 0xf, 0xf, true)); }
DI float dpp_shr1w(float prev, float x) { return __builtin_bit_cast(float, __builtin_amdgcn_update_dpp(__builtin_amdgcn_update_dpp(0, __builtin_bit_cast(int, prev), 0x121, 0xf, 0xf, true), __builtin_bit_cast(int, x), 0x111, 0xf, 0xf, false)); }
DI float dpp_shr2w(float prev, float x) { return __builtin_bit_cast(float, __builtin_amdgcn_update_dpp(__builtin_amdgcn_update_dpp(0, __builtin_bit_cast(int, prev), 0x122, 0xf, 0xf, true), __builtin_bit_cast(int, x), 0x112, 0xf, 0xf, false)); }
DI f32x4 dpp_shr1w(f32x4 p, f32x4 x) { return (f32x4){dpp_shr1w(p[0], x[0]), dpp_shr1w(p[1], x[1]), dpp_shr1w(p[2], x[2]), dpp_shr1w(p[3], x[3])}; }
DI f32x4 dpp_shr2w(f32x4 p, f32x4 x) { return (f32x4){dpp_shr2w(p[0], x[0]), dpp_shr2w(p[1], x[1]), dpp_shr2w(p[2], x[2]), dpp_shr2w(p[3], x[3])}; }
DI f32x4 dpp_shr1(f32x4 x) { return (f32x4){dpp_shr1(x[0]), dpp_shr1(x[1]), dpp_shr1(x[2]), dpp_shr1(x[3])}; }
DI f32x4 dpp_shr2(f32x4 x) { return (f32x4){dpp_shr2(x[0]), dpp_shr2(x[1]), dpp_shr2(x[2]), dpp_shr2(x[3])}; }
DI u32x4 pack8(const f32x4& a, const f32x4& b) { u32x4 w; w.x = pkbf(a[0], a[1]); w.y = pkbf(a[2], a[3]); w.z = pkbf(b[0], b[1]); w.w = pkbf(b[2], b[3]); return w; }
struct EpiConv {
    static constexpr bool PERM = true, AFTER_DRAIN = false;
    bf16* Gm; bf16* UE; bf16* US; const float* wc; const float* bc; float* ocp;
    DI void operator()(const f32x4 (&acc)[2][2][4][2], const pg8::Unit& u, int wr, int wcol, int fr, int fq) const {
        const int cw = wcol * 32 + 8 * fq, ucol = 256 * u.pn + cw, f = 128 * u.pn + cw, rowb = u.pm * 256 + wr * 64 + fr;
        if (u.pm >= 32) {
#pragma unroll
            for (int ai = 0; ai < 2; ++ai)
#pragma unroll
                for (int m = 0; m < 4; ++m) { bf16* rp = US + (size_t)(rowb + 128 * ai + 16 * m - TP) * F2 + ucol;
                    *(u32x4*)rp = pack8(acc[ai][0][m][0], acc[ai][0][m][1]); *(u32x4*)(rp + 128) = pack8(acc[ai][1][m][0], acc[ai][1][m][1]); }
            return;
        }
        const CTaps t = ctaps_load(wc, bc, f);
        const int slot = fr < 2 ? fr : fr - 12;
#pragma unroll
        for (int ai = 0; ai < 2; ++ai)
#pragma unroll
            for (int m = 0; m < 4; ++m) {
                const int row = rowb + 128 * ai + 16 * m;
                u32x4 w; unsigned* wp = (unsigned*)&w;
#pragma unroll
                for (int hh = 0; hh < 2; ++hh) { const f32x4 cg = acc[ai][0][m][hh], cv = acc[ai][1][m][hh];
                    if (m == 0) conv_half(t, hh, dpp_shr2(cg), dpp_shr1(cg), cg, dpp_shr2(cv), dpp_shr1(cv), cv, wp[2 * hh], wp[2 * hh + 1]);
                    else { const f32x4 qg = acc[ai][0][m - 1][hh], qv = acc[ai][1][m - 1][hh];
                        conv_half(t, hh, dpp_shr2w(qg, cg), dpp_shr1w(qg, cg), cg, dpp_shr2w(qv, cv), dpp_shr1w(qv, cv), cv, wp[2 * hh], wp[2 * hh + 1]); }
                    __builtin_amdgcn_sched_barrier(0); }
                *(u32x4*)(Gm + (size_t)row * FF + f) = w;
                if ((m == 0 && fr < 2) || (m == 3 && fr >= 14)) { bf16* ep = UE + ((size_t)(row >> 6) * 4 + slot) * F2 + ucol; *(u32x4*)ep = pack8(acc[ai][0][m][0], acc[ai][0][m][1]); *(u32x4*)(ep + 128) = pack8(acc[ai][1][m][0], acc[ai][1][m][1]); }
                if (row >= TP - 2) { float* oc = ocp + (size_t)(row - (TP - 2)) * F2 + f; *(f32x4*)oc = acc[ai][0][m][0]; *(f32x4*)(oc + 4) = acc[ai][0][m][1]; *(f32x4*)(oc + FF) = acc[ai][1][m][0]; *(f32x4*)(oc + FF + 4) = acc[ai][1][m][1]; }
            }
    }
};
struct CRaw { u32x4 a, c; };
DI CRaw craw_ld(const bf16* p) { CRaw r; r.a = *(const u32x4*)p; r.c = *(const u32x4*)(p + 128); return r; }
DI CRow crow_cvt(const CRaw& q) { CRow r; const u32x4 a = q.a, c = q.c;
    r.g[0] = (f32x4){bflo(a.x), bfhi(a.x), bflo(a.y), bfhi(a.y)}; r.g[1] = (f32x4){bflo(a.z), bfhi(a.z), bflo(a.w), bfhi(a.w)};
    r.v[0] = (f32x4){bflo(c.x), bfhi(c.x), bflo(c.y), bfhi(c.y)}; r.v[1] = (f32x4){bflo(c.z), bfhi(c.z), bflo(c.w), bfhi(c.w)}; return r; }
DI void conv_fix4(int strip, int g0, const bf16* UE, const float* wc, const float* bc, bf16* G, int lane) {
    const int f = 512 * strip + 8 * lane;
    if (f >= FF) return;
    const int ucol = 256 * (f >> 7) + (f & 127);
    const CTaps t = ctaps_load(wc, bc, f);
    CRow p2 = g0 ? crow_bf16i(UE + ((size_t)(g0 - 1) * 4 + 2) * F2 + ucol) : crow_zero();
    CRow p1 = g0 ? crow_bf16i(UE + ((size_t)(g0 - 1) * 4 + 3) * F2 + ucol) : crow_zero();
#pragma unroll 1
    for (int h = 0; h < 4; ++h) {
        CRaw e[4];
#pragma unroll
        for (int s = 0; s < 4; ++s) e[s] = craw_ld(UE + ((size_t)(g0 + h) * 4 + s) * F2 + ucol);
        const int r = 64 * (g0 + h);
        const CRow c0 = crow_cvt(e[0]), c1 = crow_cvt(e[1]);
        *(u32x4*)(G + (size_t)r * FF + f) = conv_out(t, p2, p1, c0);
        *(u32x4*)(G + (size_t)(r + 1) * FF + f) = conv_out(t, p1, c0, c1);
        p2 = crow_cvt(e[2]); p1 = crow_cvt(e[3]);
    }
}
DI void conv_sample(int strip, int b, const bf16* US, const float* st, const float* wc, const float* bc, bf16* G, float* o0, float* o1, int lane) {
    const int f = 512 * strip + 8 * lane;
    if (f >= FF) return;
    const int ucol = 256 * (f >> 7) + (f & 127);
    const CTaps t = ctaps_load(wc, bc, f);
    CRow p2 = crow_f32(st + f), p1 = crow_f32(st + F2 + f), cu[4];
#pragma unroll
    for (int i = 0; i < 4; ++i) cu[i] = crow_bf16i(US + (size_t)(4 * b + i) * F2 + ucol);
#pragma unroll
    for (int i = 0; i < 4; ++i) {
        *(u32x4*)(G + (size_t)(TP + 4 * b + i) * FF + f) = conv_out(t, p2, p1, cu[i]);
        p2 = p1; p1 = cu[i];
    }
    *(f32x4*)(o0 + f) = cu[2].g[0]; *(f32x4*)(o0 + f + 4) = cu[2].g[1]; *(f32x4*)(o0 + FF + f) = cu[2].v[0]; *(f32x4*)(o0 + FF + f + 4) = cu[2].v[1];
    *(f32x4*)(o1 + f) = cu[3].g[0]; *(f32x4*)(o1 + f + 4) = cu[3].g[1]; *(f32x4*)(o1 + FF + f) = cu[3].v[0]; *(f32x4*)(o1 + FF + f + 4) = cu[3].v[1];
}

__global__ void __launch_bounds__(NWAVES * 64, 2) hymba_fwd(Args args) {
    extern __shared__ __attribute__((aligned(16))) unsigned char lds_raw[];
    LAS unsigned char* lds = (LAS unsigned char*)lds_raw;
    const int tid = threadIdx.x, lane = tid & 63, wave = __builtin_amdgcn_readfirstlane(tid >> 6);
    const int G = gridDim.x, bid = blockIdx.x;
    unsigned char* ws = args.ws;
    unsigned* ctl = (unsigned*)(ws + WS_CTL);
    for (int u = tid; u < LDS_SCR / 4; u += NWAVES * 64) ((LAS unsigned*)lds)[u] = 0u;
    __syncthreads();
    XcdBarrier bar = xcd_barrier_post(ctl + CW_BAR + args.li * XCD_BAR_WORDS, (volatile LAS unsigned*)lds + 8);
    LAS unsigned char* scr = lds + LDS_SCR;
    const int gw = bid * NWAVES + wave, NGW = G * NWAVES;

    const float* xp = args.in[I_XP]; const float* xs = args.in[I_XS];
    float* MOD = (float*)(ws + WS_MOD);
    bf16* WIN = (bf16*)(ws + WS_WIN); bf16* WO = (bf16*)(ws + WS_WO); bf16* WUP = (bf16*)(ws + WS_WUP); bf16* WDN = (bf16*)(ws + WS_WDN);
    bf16* X1 = (bf16*)(ws + WS_X1); bf16* X2 = (bf16*)(ws + WS_X2); bf16* H = (bf16*)(ws + WS_H); bf16* MIX = (bf16*)(ws + WS_MIX); bf16* PROJ = (bf16*)(ws + WS_PROJ);
    unsigned char* CHK = ws + WS_CHK; unsigned char* VTF = ws + WS_VTF;
    bf16* OIA = (bf16*)(ws + WS_OIA); unsigned char* SPF = ws + WS_SPF; bf16* UE = (bf16*)(ws + WS_UE); bf16* US = (bf16*)(ws + WS_US); bf16* GB = (bf16*)(ws + WS_G);
    float* out = args.out; bf16* SLAB = (bf16*)(ws + WS_SLAB);

    const int lo = args.ph_lo, hi = args.ph_hi;
#define IN(k) (lo <= (k) && (k) < hi)
#define SEAM(k) do { if (IN(k) && IN((k) + 1)) xcd_barrier(bar); } while (0)

    if (IN(0)) {
        if (bid < 192) adaln_block(8 * bid, args.in[I_CS], args.in[I_CP], args.in[I_WADA], args.in[I_BADA], MOD, scr, opq(tid));
        LAS unsigned char* ws_scr = scr + wave * 8192;
        constexpr int I_I = 64 * (NINP / 64), I_O = I_O_P0;
        constexpr int NIT = I_I + I_O, BATCH = 32;
        for (int rnd = 0;; ++rnd) {
            volatile LAS unsigned* slot = (volatile LAS unsigned*)lds + 16 + (rnd & 1);
            if (tid == 0) *slot = __hip_atomic_fetch_add(ctl + CW_WORK, (unsigned)BATCH, __ATOMIC_RELAXED, __HIP_MEMORY_SCOPE_AGENT);
            __syncthreads();
            const int base = (int)*slot;
            if (base >= NIT) break;
#pragma unroll 1
            for (int it = base + wave; it < base + BATCH && it < NIT; it += NWAVES) {
                if (it < I_I) tr_win(args.in[I_WIN], WIN, it, ws_scr, opq(lane));
                else tr_plain(args.in[I_WO], D, D, WO, it - I_I, ws_scr, opq(lane));
            }
        }
    }
    if (IN(0) && IN(2)) xcd_barrier(bar);
    if (IN(2)) {
        for (int pr = bid; pr < TS / 2; pr += G)
            sample_pair<0>(pr, xs, MOD, 0, nullptr, nullptr, args.in[I_GNORM], D, 0, H + (size_t)TP * D, nullptr, (LAS float*)scr + 32, opq(tid));
        for (int r = gw; r < TP; r += NGW) { const float* m = MOD + (size_t)128 * NMOD; modnorm_row(xp + (size_t)r * D, args.in[I_GNORM], m + 4096, m, H + (size_t)r * D, opq(lane)); }
    }
    SEAM(2);
    if (IN(3)) {
        pg8::Gemm g{H, WIN, MROWS, NINP, D}; pg8::StaticOrder S; S.init(MROWS, NINP, G, bid, D);
        pg8::EpiBf16 E{PROJ, NINP};
        pg8::gemm_phase<pg8::EpiBf16, pg8::StaticOrder, true, true>(scr, g, S, E);
        const int nfull = ((MROWS / 256) * (NINP / 256)) % G;
        if (nfull == 0 || bid >= nfull) {
            LAS unsigned char* ws_scr = scr + wave * 8192;
            const int w0 = nfull ? (bid - nfull) * NWAVES + wave : gw, nw = nfull ? (G - nfull) * NWAVES : NGW;
#pragma unroll 1
            for (int it = I_O_P0 + w0; it < 64 * 64; it += nw) tr_plain(args.in[I_WO], D, D, WO, it, ws_scr, opq(lane));
        }
    }
    SEAM(3);
    if (IN(4)) {
        for (int rnd = 0;; ++rnd) {
            volatile LAS unsigned* slot = (volatile LAS unsigned*)lds + 16 + (rnd & 1);
            if (tid == 0) *slot = __hip_atomic_fetch_add(ctl + CW_WORK4, 1u, __ATOMIC_RELAXED, __HIP_MEMORY_SCOPE_AGENT);
            __syncthreads();
            const int id = (int)*slot;
            if (id >= 1024) break;
            const int u = id >> 1;
            if (id & 1) { if (!(args.pad & 4)) gla_local_unit(u & 127, u >> 7, PROJ, args.in[I_WAUP], args.in[I_BA], CHK, VTF, OIA, scr, opq(tid), (args.pad >> 4) & 7); }
            else { if (!(args.pad & 8)) gla_sample_unit(u >> 2, u & 3, PROJ, args.in[I_WAUP], args.in[I_BA], args.in[I_GGLA], args.in[I_SGLA], out + O_GLA_S, MIX, scr, opq(tid)); }
        }
    }
    SEAM(4);
    if (IN(5)) {
        if (bid < 128) { if (!(args.pad & 1)) {
            const int x = bid & 7, i = bid >> 3;
            gla_scan_block(x >> 1, (x & 1) * 16 + i, CHK, VTF, SPF, out + O_GLA_P, scr, opq(tid)); __syncthreads(); }
        }
        if (!(args.pad & 2)) for (int rnd = 0;; ++rnd) {
            volatile LAS unsigned* slot = (volatile LAS unsigned*)lds + 16 + (rnd & 1);
            if (tid == 0) *slot = __hip_atomic_fetch_add(ctl + CW_WORK5, 1u, __ATOMIC_RELAXED, __HIP_MEMORY_SCOPE_AGENT);
            __syncthreads();
            const int id = (int)*slot;
            constexpr int NB_U = (64 * (F2 / 64)) / (2 * NWAVES);
            if (id >= 9 * 256) break;
            const int g = id / 9, r = id % 9;
            if (r % 3 == 0) {
                const int unit = 3 * g + r / 3;
                if (unit < 256) swa_prompt_unit(unit >> 2, unit & 3, PROJ, args.in[I_SINK], MIX, out + O_K_P, out + O_V_P, scr, opq(tid));
                else { const int u = unit - 256; swa_sample_unit(u >> 2, u & 3, PROJ, args.in[I_SK], args.in[I_SV], args.in[I_SINK], MIX, out + O_K_S, out + O_V_S, scr, opq(tid)); }
            } else {
                const int cb = 6 * g + (r - r / 3 - 1);
                if (cb < NB_U) tr_wup2(args.in[I_WUP], WUP, cb * 2 * NWAVES + wave, cb * 2 * NWAVES + NWAVES + wave, scr + wave * 8192, opq(lane));
                __syncthreads();
            }
        }
    }
    SEAM(5);
    if (IN(6)) {
        for (int u = bid; u < 512; u += G) gla_out_unit(u & 127, u >> 7, CHK, SPF, OIA, PROJ, args.in[I_GGLA], MIX, scr, opq(tid));
    }
    SEAM(6);
    if (IN(7)) {
        pg8::Gemm g{MIX, WO, MROWS, D, D}; pg8::TailOrder S; S.init(G, bid, D);
        pg8::EpiResid<false> E{xp, MOD + 2 * D, X1, SLAB, D / 128};
        pg8::gemm_phase<pg8::EpiResid<false>, pg8::TailOrder, true, true>(scr, g, S, E);
    }
    SEAM(7);
    if (IN(8)) {
        for (int pr = bid; pr < TS / 2; pr += G)
            sample_pair<1>(pr, xs, MOD, 2 * D, SLAB, X1 + (size_t)TP * D, args.in[I_GNORM] + D, 4 * D, 3 * D, H + (size_t)TP * D, nullptr, (LAS float*)scr + 32, opq(tid));
        for (int r = gw; r < TP; r += NGW) { const float* m = MOD + (size_t)128 * NMOD; modnorm_row(X1 + (size_t)r * D, args.in[I_GNORM] + D, m + 4 * D, m + 3 * D, H + (size_t)r * D, opq(lane)); }
    }
    SEAM(8);
    if (IN(9)) {
        constexpr int GG = 244;
        if (bid < GG || G <= GG) {
            pg8::Gemm g{H, WUP, MROWS, F2, D}; pg8::StaticOrder S; S.init(MROWS, F2, G <= GG ? G : GG, bid, D);
            EpiConv E{GB, UE, US, args.in[I_WCONV], args.in[I_BCONV], out + O_CONV_P};
            pg8::gemm_phase<EpiConv, pg8::StaticOrder, true, true>(scr, g, S, E);
        }
        if (bid >= GG || G <= GG) {
            LAS unsigned char* ws_scr = scr + wave * 8192;
            const int w0 = G <= GG ? gw : (bid - GG) * NWAVES + wave, nw = G <= GG ? NGW : (G - GG) * NWAVES;
#pragma unroll 1
            for (int it = w0; it < (FF / 64) * 64; it += nw) tr_plain(args.in[I_WDN], FF, D, WDN, it, ws_scr, opq(lane));
        }
    }
    SEAM(9);
    if (IN(10)) {
        for (int it = gw; it < 32 * 22 + 128 * 22; it += NGW) {
            if (it < 32 * 22) conv_fix4(it % 22, 4 * (it / 22), UE, args.in[I_WCONV], args.in[I_BCONV], GB, opq(lane));
            else { const int k = it - 32 * 22, b = k / 22, strip = k % 22;
                conv_sample(strip, b, US, args.in[I_SCONV] + (size_t)b * 2 * F2, args.in[I_WCONV], args.in[I_BCONV], GB, out + O_CONV_S + (size_t)b * 2 * F2, out + O_CONV_S + (size_t)(b * 2 + 1) * F2, opq(lane)); }
        }
    }
    SEAM(10);
    if (IN(11)) {
        pg8::Gemm g{GB, WDN, MROWS, D, FF}; pg8::TailOrder S; S.init(G, bid, FF);
        pg8::EpiResid<true> E{X1, MOD + 5 * D, X2, SLAB, FF / 128};
        pg8::gemm_phase<pg8::EpiResid<true>, pg8::TailOrder, true, true>(scr, g, S, E);
    }
    SEAM(11);
    if (IN(12)) {
        for (int pr = bid; pr < TS / 2; pr += G)
            sample_pair<2>(pr, X1 + (size_t)TP * D, MOD, 5 * D, SLAB, nullptr, args.in[I_GFIN], 0, 0, nullptr, out + O_Y + (size_t)TP * D, (LAS float*)scr + 32, opq(tid));
        for (int r = gw; r < TP; r += NGW) finalnorm_row(X2 + (size_t)r * D, out + O_Y + (size_t)r * D, args.in[I_GFIN], opq(lane));
    }
#undef IN
#undef SEAM
}

#ifndef MK_N_LAUNCHES
#define MK_N_LAUNCHES 1
#endif
extern "C" void kernel_launch(void* const* d_in, const int* in_sizes, int n_in, void* d_out, int out_size, void* d_ws, size_t ws_size, hipStream_t stream) {
    static int grid = 0;
    if (grid == 0) {
        if (n_in != 22 || (size_t)out_size != O_END || ws_size < WS_END) { fprintf(stderr, "kernel_launch: unexpected shapes (n_in %d, out %d, ws %zu); nothing launched\n", n_in, out_size, ws_size); grid = -1; return; }
        int dev = 0, cus = 0, per_cu = 0;
        if (hipGetDevice(&dev) != hipSuccess || hipDeviceGetAttribute(&cus, hipDeviceAttributeMultiprocessorCount, dev) != hipSuccess) { grid = -1; return; }
        if (hipFuncSetAttribute((const void*)hymba_fwd, hipFuncAttributeMaxDynamicSharedMemorySize, LDS_BYTES) != hipSuccess) { fprintf(stderr, "kernel_launch: hipFuncSetAttribute failed\n"); grid = -1; return; }
        if (hipOccupancyMaxActiveBlocksPerMultiprocessor(&per_cu, (const void*)hymba_fwd, NWAVES * 64, LDS_BYTES) != hipSuccess || per_cu < 1) { fprintf(stderr, "kernel_launch: occupancy query says %d\n", per_cu); }
        (void)hipGetLastError();
        grid = cus;
        if (grid < 128) { fprintf(stderr, "kernel_launch: %d CUs: this kernel is built for a 256-CU device\n", grid); grid = -1; return; }
    }
    if (grid < 0) return;
    (void)hipMemsetAsync((char*)d_ws + WS_CTL, 0, CTL_ZERO_BYTES, stream);
    Args a{};
    for (int i = 0; i < 22; ++i) a.in[i] = (const float*)d_in[i];
    a.out = (float*)d_out; a.ws = (unsigned char*)d_ws;
#if defined(PROBE_A)
#ifndef PROBE_PAD
#define PROBE_PAD 0
#endif
    const int cuts[3][2] = {{0, PROBE_B}, {PROBE_A, PROBE_B}, {PROBE_B, 13}};
    for (int li = 0; li < 3; ++li) { a.ph_lo = cuts[li][0]; a.ph_hi = cuts[li][1]; a.li = li; a.pad = (li == 1) ? PROBE_PAD : 0; if (a.ph_lo < a.ph_hi) hipLaunchKernelGGL(hymba_fwd, dim3(grid), dim3(NWAVES * 64), LDS_BYTES, stream, a); }
#else
    a.ph_lo = 0; a.ph_hi = 13; a.li = 0;
    hipLaunchKernelGGL(hymba_fwd, dim3(grid), dim3(NWAVES * 64), LDS_BYTES, stream, a);
#endif
}
```

```cpp
#include <hip/hip_runtime.h>
#include <cstdio>
#include <cstdint>
namespace pg8 {
#define PG8_LAS __attribute__((address_space(3)))
typedef unsigned short bf16_t;
typedef short bf16x8 __attribute__((ext_vector_type(8)));
typedef float f32x4 __attribute__((ext_vector_type(4)));
typedef unsigned u32x4 __attribute__((ext_vector_type(4)));
constexpr int BM = 256, BK = 64, HALF = 128, HTB = HALF * BK * 2  , STAGE_BYTES = 8 * HTB, NXCD = 8, WGM = 8;

__host__ __device__ __forceinline__ int lds_byte(int r, int c) { const int st = (r >> 4) * 2 + (c >> 5), rr = r & 15, cc = c & 31, ob = rr * 64 + cc * 2; return st * 1024 + (ob ^ (((ob >> 9) & 1) << 5)); }
__host__ __device__ __forceinline__ void stage_rc(int b, int& R, int& C) { const int st = b / 1024, sb = b % 1024, swz = sb ^ (((sb >> 9) & 1) << 5); R = (st >> 1) * 16 + swz / 64; C = (st & 1) * 32 + (swz % 64) / 2; }
__host__ __device__ __forceinline__ int perm32(int rho) { const int n = rho >> 4, i = rho & 15; return 8 * (i >> 2) + 4 * n + (i & 3); }

struct Unit { int pm, pn, kt0, nt; };
struct Gemm { const bf16_t* A; const bf16_t* Bt; int M, N, K; };

struct StaticOrder {
    int nM, nN, nwg, G, c, ntk;
    __host__ __device__ void init(int M, int N, int G_, int c_, int K) { nM = M / BM; nN = N / BM; nwg = nM * nN; G = G_; c = c_; ntk = K / BK; }
    __host__ __device__ bool next(int i, Unit& u) const {
        const long L = (long)i * G + c; if (L >= nwg) return false;
        int wgid = (int)L; { const int q = nwg / NXCD, r = nwg % NXCD, xcd = wgid % NXCD, off = wgid / NXCD; wgid = (xcd < r ? xcd * (q + 1) : r * (q + 1) + (xcd - r) * q) + off; }
        const int nig = WGM * nN, gid = wgid / nig, fm = gid * WGM, gsz = (nM - fm) < WGM ? (nM - fm) : WGM;
        u.pm = fm + ((wgid % nig) % gsz); u.pn = (wgid % nig) / gsz; u.kt0 = 0; u.nt = ntk; return true;
    }
    __device__ __forceinline__ void a_ready(const Unit&) const {}
    __device__ __forceinline__ void done(const Unit&) const {}
};

typedef float f32x2_t __attribute__((ext_vector_type(2)));
typedef __bf16 bf16x2_t __attribute__((ext_vector_type(2)));
__device__ __forceinline__ unsigned cvt_pk_bf16(float lo, float hi) { const f32x2_t v = {lo, hi}; return __builtin_bit_cast(unsigned, __builtin_convertvector(v, bf16x2_t)); }

struct RowOrder {
    int n, c, ntk;
    __device__ __forceinline__ bool next(int i, Unit& u) const { if (i > 0 || c >= n) return false; u.pm = 0; u.pn = c; u.kt0 = 0; u.nt = ntk; return true; }
    __device__ __forceinline__ void a_ready(const Unit&) const {}
    __device__ __forceinline__ void done(const Unit&) const {}
};

struct TailOrder {
    StaticOrder P; int G, c, nd;
    __device__ __forceinline__ void init(int G_, int c_, int K) { P.init(8192, 4096, G_, c_, K); G = G_; c = c_; nd = K / 128; }
    __device__ __forceinline__ bool next(int i, Unit& u) const {
        if (G == 256 && (c & 1)) { if (i > 2) return false; i = (i == 0) ? 2 : i - 1; }
        const long L = (long)i * G + c;
        if (L < 512) return P.next(i, u);
        if (L >= 768) return false;
        const int su = (int)L - 512, ks = su >> 5, base = nd >> 3, rem = nd & 7;
        u.pn = su & 15; u.pm = 32 + ((su >> 4) & 1);
        u.kt0 = 2 * (ks * base + (ks < rem ? ks : rem)); u.nt = 2 * (base + (ks < rem ? 1 : 0));
        return true;
    }
    __device__ __forceinline__ void a_ready(const Unit&) const {}
    __device__ __forceinline__ void done(const Unit&) const {}
};

struct EpiF32 {
    static constexpr bool PERM = false, AFTER_DRAIN = false;
    float* C; int ldc; const float* bias;
    __device__ __forceinline__ void operator()(const f32x4 (&acc)[2][2][4][2], const Unit& u, int wr, int wc, int fr, int fq) const {
        const int row0 = u.pm * BM + wr * 64 + fr, col0 = u.pn * BM + wc * 32 + 4 * fq;
        f32x4 bv[2][2];
#pragma unroll
        for (int bj = 0; bj < 2; ++bj)
#pragma unroll
            for (int n = 0; n < 2; ++n) bv[bj][n] = *(const f32x4*)(bias + col0 + bj * HALF + n * 16);
#pragma unroll
        for (int ai = 0; ai < 2; ++ai)
#pragma unroll
            for (int m = 0; m < 4; ++m) { float* rowp = C + (size_t)(row0 + ai * HALF + m * 16) * ldc + col0;
#pragma unroll
                for (int bj = 0; bj < 2; ++bj)
#pragma unroll
                    for (int n = 0; n < 2; ++n) *(f32x4*)(rowp + bj * HALF + n * 16) = acc[ai][bj][m][n] + bv[bj][n]; }
    }
};
struct EpiBf16 {
    static constexpr bool PERM = true, AFTER_DRAIN = false;
    bf16_t* O; int ldc;
    __device__ __forceinline__ void operator()(const f32x4 (&acc)[2][2][4][2], const Unit& u, int wr, int wc, int fr, int fq) const {
        const int row0 = u.pm * BM + wr * 64 + fr, col0 = u.pn * BM + wc * 32 + 8 * fq;
#pragma unroll
        for (int ai = 0; ai < 2; ++ai)
#pragma unroll
            for (int m = 0; m < 4; ++m) { bf16_t* rowp = O + (size_t)(row0 + ai * HALF + m * 16) * ldc + col0;
#pragma unroll
                for (int bj = 0; bj < 2; ++bj) { const f32x4 v0 = acc[ai][bj][m][0], v1 = acc[ai][bj][m][1];
                    u32x4 w; w.x = cvt_pk_bf16(v0[0], v0[1]); w.y = cvt_pk_bf16(v0[2], v0[3]); w.z = cvt_pk_bf16(v1[0], v1[1]); w.w = cvt_pk_bf16(v1[2], v1[3]);
                    *(u32x4*)(rowp + bj * HALF) = w; } }
    }
};
template <bool BASE_BF16> struct EpiResid {
    static constexpr bool PERM = true, AFTER_DRAIN = false;
    const void* bp; const float* gate; bf16_t* out; bf16_t* slab; int nd;
    __device__ __forceinline__ void operator()(const f32x4 (&acc)[2][2][4][2], const Unit& u, int wr, int wc, int fr, int fq) const {
        const int row0 = u.pm * BM + wr * 64 + fr, col0 = u.pn * BM + wc * 32 + 8 * fq;
        if (u.pm < 32) {
            const float* grow = gate + (size_t)128 * 24576 + col0;
            f32x4 gv[2][2];
#pragma unroll
            for (int bj = 0; bj < 2; ++bj) { gv[bj][0] = *(const f32x4*)(grow + bj * HALF); gv[bj][1] = *(const f32x4*)(grow + bj * HALF + 4); }
#pragma unroll
            for (int ai = 0; ai < 2; ++ai)
#pragma unroll
                for (int mh = 0; mh < 2; ++mh) {
                    f32x4 x[2][2][2];
#pragma unroll
                    for (int mm = 0; mm < 2; ++mm)
#pragma unroll
                        for (int bj = 0; bj < 2; ++bj) { const size_t ro = (size_t)(row0 + ai * HALF + (2 * mh + mm) * 16) * 4096 + col0 + bj * HALF;
                            if (BASE_BF16) { const u32x4 b = *(const u32x4*)((const bf16_t*)bp + ro);
                                x[mm][bj][0] = (f32x4){__uint_as_float(b.x << 16), __uint_as_float(b.x & 0xffff0000u), __uint_as_float(b.y << 16), __uint_as_float(b.y & 0xffff0000u)};
                                x[mm][bj][1] = (f32x4){__uint_as_float(b.z << 16), __uint_as_float(b.z & 0xffff0000u), __uint_as_float(b.w << 16), __uint_as_float(b.w & 0xffff0000u)}; }
                            else { const float* p = (const float*)bp + ro; x[mm][bj][0] = *(const f32x4*)p; x[mm][bj][1] = *(const f32x4*)(p + 4); } }
#pragma unroll
                    for (int mm = 0; mm < 2; ++mm)
#pragma unroll
                        for (int bj = 0; bj < 2; ++bj) { const int m = 2 * mh + mm; const size_t ro = (size_t)(row0 + ai * HALF + m * 16) * 4096 + col0 + bj * HALF;
                            const f32x4 v0 = x[mm][bj][0] + gv[bj][0] * acc[ai][bj][m][0], v1 = x[mm][bj][1] + gv[bj][1] * acc[ai][bj][m][1];
                            u32x4 w; w.x = cvt_pk_bf16(v0[0], v0[1]); w.y = cvt_pk_bf16(v0[2], v0[3]); w.z = cvt_pk_bf16(v1[0], v1[1]); w.w = cvt_pk_bf16(v1[2], v1[3]);
                            *(u32x4*)(out + ro) = w; }
                }
        } else {
            bf16_t* sl = slab + (size_t)((4 * u.kt0 + 7) / nd) * 512 * 4096;
#pragma unroll
            for (int ai = 0; ai < 2; ++ai)
#pragma unroll
                for (int m = 0; m < 4; ++m) { bf16_t* orow = sl + (size_t)(row0 + ai * HALF + m * 16 - 8192) * 4096 + col0;
#pragma unroll
                    for (int bj = 0; bj < 2; ++bj) { const f32x4 v0 = acc[ai][bj][m][0], v1 = acc[ai][bj][m][1];
                        u32x4 w; w.x = cvt_pk_bf16(v0[0], v0[1]); w.y = cvt_pk_bf16(v0[2], v0[3]); w.z = cvt_pk_bf16(v1[0], v1[1]); w.w = cvt_pk_bf16(v1[2], v1[3]);
                        *(u32x4*)(orow + bj * HALF) = w; } }
        }
    }
};

template <class Epi, class Sched, bool ALIGN_EPI = false, bool SP2 = false>
__device__ __forceinline__ void gemm_phase(PG8_LAS unsigned char* lds, const Gemm g, const Sched& S, const Epi& E) {
    const int tid = threadIdx.x, wid = __builtin_amdgcn_readfirstlane(tid >> 6), lane = tid & 63, wr = wid >> 2, wc = wid & 3, fr = lane & 15, fq = lane >> 4;
    const int K = g.K;
    unsigned voffA[2], voffB[2];
#pragma unroll
    for (int i = 0; i < 2; ++i) { int R, C; stage_rc(tid * 16 + i * 8192, R, C); const int Rb = Epi::PERM ? ((R & ~31) + perm32(R & 31)) : R;
        voffA[i] = (unsigned)(R * K + C) * 2u; (void)Rb; voffB[i] = (unsigned)(tid * 16 + i * 8192); }
    const size_t kstep = (size_t)(BK * 2);
    const size_t kstepB = (size_t)HTB;
    static_assert(Epi::PERM, "the pre-tiled weight copies carry the PERM row order");
    const size_t hstep = (size_t)HALF * K * 2;
    const size_t tstep = 2 * hstep;
    const unsigned ldsw = (unsigned)wid * 1024u;
    const int aoff = lds_byte(wr * 64 + fr, fq * 8), boff = lds_byte(wc * 32 + fr, fq * 8);
#define PG8_SA(b, h) (((b) * 2 + (h)) * HTB)
#define PG8_SB(b, h) ((4 + (b) * 2 + (h)) * HTB)
#define PG8_STAGE(bufoff, gbase, voff) do { _Pragma("unroll") for (int _i = 0; _i < 2; ++_i) \
        __builtin_amdgcn_global_load_lds((const unsigned*)((const char*)(gbase) + (voff)[_i]), (PG8_LAS unsigned*)(lds + (bufoff) + ldsw + _i * 8192), 16, 0, 0); } while (0)
#define PG8_LDA(dst, b, h) do { _Pragma("unroll") for (int m = 0; m < 4; ++m) _Pragma("unroll") for (int k = 0; k < 2; ++k) dst[m][k] = *(const PG8_LAS bf16x8*)(lds + PG8_SA(b, h) + aoff + m * 2048 + k * 1024); } while (0)
#define PG8_LDB(dst, b, h) do { _Pragma("unroll") for (int n = 0; n < 2; ++n) _Pragma("unroll") for (int k = 0; k < 2; ++k) dst[n][k] = *(const PG8_LAS bf16x8*)(lds + PG8_SB(b, h) + boff + n * 2048 + k * 1024); } while (0)
#define PG8_MMA(ai, bj, At, Bt) do { __builtin_amdgcn_s_setprio(1); _Pragma("unroll") for (int m = 0; m < 4; ++m) _Pragma("unroll") for (int n = 0; n < 2; ++n) _Pragma("unroll") for (int k = 0; k < 2; ++k) \
        acc[ai][bj][m][n] = __builtin_amdgcn_mfma_f32_16x16x32_bf16(Bt[n][k], At[m][k], acc[ai][bj][m][n], 0, 0, 0); __builtin_amdgcn_s_setprio(0); } while (0)
#define PG8_WAIT_V(n) asm volatile("s_waitcnt vmcnt(" #n ")" ::: "memory")
#define PG8_WAIT_L(n) asm volatile("s_waitcnt lgkmcnt(" #n ")" ::: "memory")
#define PG8_BAR __builtin_amdgcn_s_barrier()
#define PG8_SCHED __builtin_amdgcn_sched_barrier(0)
    Unit cur, nxt; int ui = 0;
    if (!S.next(0, cur)) return;
    int nt = cur.nt;
    f32x4 acc[2][2][4][2];
#pragma unroll
    for (int a = 0; a < 2; ++a)
#pragma unroll
        for (int b = 0; b < 2; ++b)
#pragma unroll
            for (int m = 0; m < 4; ++m)
#pragma unroll
                for (int n = 0; n < 2; ++n) acc[a][b][m][n] = (f32x4){0.f, 0.f, 0.f, 0.f};
    bf16x8 At[4][2], B0[2][2], B1[2][2];
    const char* cA = (const char*)g.A + (size_t)cur.pm * tstep + (size_t)cur.kt0 * kstep; const char* cB = (const char*)g.Bt + (size_t)cur.pn * tstep + (size_t)cur.kt0 * kstepB;
    S.a_ready(cur);
    if constexpr (SP2) {
        PG8_STAGE(PG8_SB(0, 0), cB, voffB); PG8_STAGE(PG8_SB(0, 1), cB + hstep, voffB); PG8_STAGE(PG8_SA(0, 0), cA, voffA); PG8_STAGE(PG8_SA(0, 1), cA + hstep, voffA);
        if (wr == 1) PG8_BAR;
        PG8_WAIT_V(2); PG8_BAR;
        PG8_STAGE(PG8_SB(1, 0), cB + kstepB, voffB); PG8_STAGE(PG8_SA(1, 0), cA + kstep, voffA); PG8_STAGE(PG8_SB(1, 1), cB + hstep + kstepB, voffB);
        PG8_WAIT_V(6); PG8_BAR;
    } else {
        PG8_STAGE(PG8_SB(0, 0), cB, voffB); PG8_STAGE(PG8_SA(0, 0), cA, voffA); PG8_STAGE(PG8_SB(0, 1), cB + hstep, voffB); PG8_STAGE(PG8_SA(0, 1), cA + hstep, voffA);
        if (wr == 1) PG8_BAR;
        PG8_WAIT_V(4); PG8_BAR;
        PG8_STAGE(PG8_SB(1, 0), cB + kstepB, voffB); PG8_STAGE(PG8_SA(1, 0), cA + kstep, voffA); PG8_STAGE(PG8_SB(1, 1), cB + hstep + kstepB, voffB);
        PG8_WAIT_V(6); PG8_BAR;
    }
    for (;;) {
        const bool has_next = S.next(ui + 1, nxt);
        const char* nA = has_next ? (const char*)g.A + (size_t)nxt.pm * tstep + (size_t)nxt.kt0 * kstep : cA; const char* nB = has_next ? (const char*)g.Bt + (size_t)nxt.pn * tstep + (size_t)nxt.kt0 * kstepB : cB;
        for (int t = 0; t < nt; t += 2) {
            const bool last = (t == nt - 2);
            const char* a1 = cA + (size_t)(t + 1) * kstep;
            const char* a2 = last ? nA : cA + (size_t)(t + 2) * kstep; const char* b2 = last ? nB : cB + (size_t)(t + 2) * kstepB;
            const char* a3 = a2 + kstep; const char* b3 = b2 + kstepB;
            if (last && has_next) S.a_ready(nxt);
            if constexpr (SP2) {
            PG8_LDB(B0, 0, 0); PG8_LDB(B1, 0, 1); PG8_SCHED; PG8_LDA(At, 0, 0); PG8_STAGE(PG8_SA(1, 1), a1 + hstep, voffA);
            PG8_WAIT_V(8); PG8_WAIT_L(0); PG8_BAR; PG8_MMA(0, 0, At, B0); PG8_MMA(0, 1, At, B1); PG8_BAR; PG8_SCHED;
            PG8_LDA(At, 0, 1); PG8_STAGE(PG8_SB(0, 0), b2, voffB); PG8_STAGE(PG8_SB(0, 1), b2 + hstep, voffB); PG8_STAGE(PG8_SA(0, 0), a2, voffA);
            PG8_WAIT_V(8); PG8_WAIT_L(0); PG8_BAR; PG8_MMA(1, 0, At, B0); PG8_MMA(1, 1, At, B1); PG8_BAR; PG8_SCHED;
            PG8_LDB(B0, 1, 0); PG8_LDB(B1, 1, 1); PG8_SCHED; PG8_LDA(At, 1, 0); PG8_STAGE(PG8_SA(0, 1), a2 + hstep, voffA);
            PG8_WAIT_V(8); PG8_WAIT_L(0); PG8_BAR; PG8_MMA(0, 0, At, B0); PG8_MMA(0, 1, At, B1); PG8_BAR; PG8_SCHED;
            PG8_LDA(At, 1, 1); PG8_STAGE(PG8_SB(1, 0), b3, voffB); PG8_STAGE(PG8_SB(1, 1), b3 + hstep, voffB); PG8_STAGE(PG8_SA(1, 0), a3, voffA);
            PG8_WAIT_V(8); PG8_WAIT_L(0); PG8_BAR; PG8_MMA(1, 0, At, B0); PG8_MMA(1, 1, At, B1); PG8_BAR; PG8_SCHED;
            } else {
            PG8_LDB(B0, 0, 0); PG8_SCHED; PG8_LDA(At, 0, 0); PG8_STAGE(PG8_SA(1, 1), a1 + hstep, voffA);
            PG8_WAIT_L(8); PG8_BAR; PG8_WAIT_L(0); PG8_MMA(0, 0, At, B0); PG8_BAR; PG8_SCHED;
            PG8_LDB(B1, 0, 1); PG8_STAGE(PG8_SB(0, 0), b2, voffB);
            PG8_BAR; PG8_WAIT_L(0); PG8_MMA(0, 1, At, B1); PG8_BAR;
            PG8_LDA(At, 0, 1); PG8_STAGE(PG8_SA(0, 0), a2, voffA);
            PG8_BAR; PG8_WAIT_L(0); PG8_MMA(1, 0, At, B0); PG8_BAR; PG8_SCHED;
            PG8_STAGE(PG8_SB(0, 1), b2 + hstep, voffB);
            PG8_WAIT_V(6); PG8_BAR; PG8_MMA(1, 1, At, B1); PG8_BAR;
            PG8_LDB(B0, 1, 0); PG8_SCHED; PG8_LDA(At, 1, 0); PG8_STAGE(PG8_SA(0, 1), a2 + hstep, voffA);
            PG8_WAIT_L(8); PG8_BAR; PG8_WAIT_L(0); PG8_MMA(0, 0, At, B0); PG8_BAR; PG8_SCHED;
            PG8_LDB(B1, 1, 1); PG8_STAGE(PG8_SB(1, 0), b3, voffB);
            PG8_BAR; PG8_WAIT_L(0); PG8_MMA(0, 1, At, B1); PG8_BAR;
            PG8_LDA(At, 1, 1); PG8_STAGE(PG8_SA(1, 0), a3, voffA);
            PG8_BAR; PG8_WAIT_L(0); PG8_MMA(1, 0, At, B0); PG8_BAR; PG8_SCHED;
            PG8_STAGE(PG8_SB(1, 1), b3 + hstep, voffB);
            PG8_WAIT_V(6); PG8_BAR; PG8_MMA(1, 1, At, B1); PG8_BAR;
            }
        }
        if constexpr (ALIGN_EPI) { if (wr == 0) PG8_BAR; }
        if constexpr (!Epi::AFTER_DRAIN) { E(acc, cur, wr, wc, fr, fq); S.done(cur); }
        if (!has_next) break;
#pragma unroll
        for (int a = 0; a < 2; ++a)
#pragma unroll
            for (int b = 0; b < 2; ++b)
#pragma unroll
                for (int m = 0; m < 4; ++m)
#pragma unroll
                    for (int n = 0; n < 2; ++n) acc[a][b][m][n] = (f32x4){0.f, 0.f, 0.f, 0.f};
        cur = nxt; cA = nA; cB = nB; ++ui; nt = cur.nt;
        if constexpr (ALIGN_EPI) { if (wr == 1) PG8_BAR; }
    }
    PG8_WAIT_V(0);
    if constexpr (!ALIGN_EPI) { if (wr == 0) PG8_BAR; }
    PG8_BAR;
    if constexpr (Epi::AFTER_DRAIN) { E.fused(acc, cur, wr, wc, fr, fq, lds, wid, lane); S.done(cur); }
#undef PG8_SA
#undef PG8_SB
#undef PG8_STAGE
#undef PG8_LDA
#undef PG8_LDB
#undef PG8_MMA
#undef PG8_WAIT_V
#undef PG8_WAIT_L
#undef PG8_BAR
#undef PG8_SCHED
}
}

constexpr int NWAVES = 8;
constexpr int D = 4096, TP = 8192, TS = 512, MROWS = TP + TS, DB = 128, DSQ = 4;
constexpr int NIN = 9232, NINP = 9472, F2 = 22016, FF = 11008, NMOD = 24576;
constexpr int PC_GQ = 0, PC_GK = 1024, PC_GV = 2048, PC_GR = 4096, PC_SQ = 6144, PC_SK = 8192, PC_SV = 8704, PC_GA = 9216;
constexpr float NORM_EPS = 1e-6f;
constexpr size_t MiB = 1u << 20;
constexpr size_t WS_CTL = 0, CTL_ZERO_BYTES = 65536;
constexpr size_t WS_CS = 1 * MiB;
constexpr size_t WS_MOD = 3 * MiB;
constexpr size_t WS_WIN = 27 * MiB;
constexpr size_t WS_WO = 101 * MiB;
constexpr size_t WS_WUP = 133 * MiB;
constexpr size_t WS_WDN = 305 * MiB;
constexpr size_t WS_X1 = 391 * MiB;
constexpr size_t WS_X2 = 459 * MiB;
constexpr size_t WS_H = 527 * MiB;
constexpr size_t WS_MIX = 595 * MiB;
constexpr size_t WS_BIG = 663 * MiB;
constexpr size_t WS_WADA = WS_BIG;
constexpr size_t WS_PROJ = 855 * MiB;
constexpr size_t WS_CHK = 1013 * MiB;
constexpr size_t WS_VTF = 1046 * MiB;
constexpr size_t WS_OIA = 1078 * MiB;
constexpr size_t WS_SPF = 1142 * MiB;
constexpr size_t WS_UE = WS_BIG;
constexpr size_t WS_US = 760 * MiB;
constexpr size_t WS_G = 1029 * MiB;
constexpr size_t WS_SLAB = 1212 * MiB;
constexpr size_t WS_END = 1276 * MiB;
static_assert(WS_UE + (size_t)2048 * F2 * 2 <= WS_US && WS_US + (size_t)TS * F2 * 2 <= WS_G && WS_G + (size_t)MROWS * FF * 2 <= WS_SLAB && WS_PROJ + (size_t)MROWS * NINP * 2 <= WS_CHK && WS_CHK + 512 * 66560 <= WS_VTF && WS_VTF + 32 * MiB <= WS_OIA && WS_WADA + (size_t)NMOD * D * 2 <= WS_PROJ, "ws map");
constexpr int CW_WORK = 64, CW_WORK4 = 128, CW_WORK5 = 192, CW_WORK5B = 256;
constexpr int CW_BAR = 4096;
constexpr size_t O_Y = 0, O_GLA_P = 35651584, O_K_P = 36175872, O_V_P = 36241408, O_CONV_P = 36306944, O_GLA_S = 36350976, O_K_S = 103459840, O_V_S = 111848448, O_CONV_S = 120237056, O_END = 125873152;
constexpr int LDS_BYTES = 147456, LDS_SCR = 1024;

#define GAS __attribute__((address_space(1)))
#define LAS __attribute__((address_space(3)))
#define DI __device__ __forceinline__
typedef unsigned short bf16;
typedef unsigned u32x4 __attribute__((ext_vector_type(4)));
typedef unsigned u32x2 __attribute__((ext_vector_type(2)));
typedef float f32x4 __attribute__((ext_vector_type(4)));
typedef short bf16x8 __attribute__((ext_vector_type(8)));
typedef short bf16x4 __attribute__((ext_vector_type(4)));
#define LDS_WAIT() asm volatile("s_waitcnt lgkmcnt(0)" ::: "memory")
#define VM_WAIT() asm volatile("s_waitcnt vmcnt(0)" ::: "memory")
#define MFMA16(a, b, c) __builtin_amdgcn_mfma_f32_16x16x32_bf16((a), (b), (c), 0, 0, 0)
DI int opq(int x) { asm volatile("" : "+v"(x)); return x; }
DI float bf2f(unsigned v) { return __uint_as_float(v << 16); }
DI float bflo(unsigned w) { return __uint_as_float(w << 16); }
DI float bfhi(unsigned w) { return __uint_as_float(w & 0xffff0000u); }
DI unsigned pkbf(float lo, float hi) { return pg8::cvt_pk_bf16(lo, hi); }
DI float wave_sum(float v) {
#pragma unroll
    for (int o = 1; o < 64; o <<= 1) v += __shfl_xor(v, o);
    return v;
}
DI float silu_f(float x) { return x / (1.0f + __expf(-x)); }
DI float logsig16(float z) { return (fminf(z, 0.0f) - __logf(1.0f + __expf(-fabsf(z)))) * 0.0625f; }
#define XB_TMO      128
#define XB_XCNT(j)  (256  + 64 * (j))
#define XB_XSUB(j)  (1280 + 64 * (j))
#define XB_XGEN(j)  (2304 + 64 * (j))
#define XB_TOP      3328
#define XB_TOPGEN   3392
#define XCD_BAR_WORDS 3456
#define XB_SPIN_CAP (1u << 18)

__device__ __forceinline__ unsigned xb_ld(unsigned* p)              { return __hip_atomic_load(p, __ATOMIC_RELAXED, __HIP_MEMORY_SCOPE_AGENT); }
__device__ __forceinline__ unsigned xb_add(unsigned* p, unsigned v) { return __hip_atomic_fetch_add(p, v, __ATOMIC_RELAXED, __HIP_MEMORY_SCOPE_AGENT); }
__device__ __forceinline__ unsigned xb_xcc_id() { return (unsigned)__builtin_amdgcn_s_getreg((3 << 11) | 20) & 0xFu; }
#define XB_SPIN(cond, bar) do { unsigned _sp = 0; while (cond) { __builtin_amdgcn_s_sleep(1); \
    if ((++_sp & 255u) == 0u) { if (xb_ld(&(bar)[XB_TMO])) break; if (_sp > XB_SPIN_CAP) { atomicAdd(&(bar)[XB_TMO], 1u); break; } } } } while (0)

struct XcdBarrier {
    unsigned* bar; unsigned x;
    volatile LAS unsigned* st;
};

__device__ __forceinline__ XcdBarrier xcd_barrier_post(unsigned* bar, volatile LAS unsigned* st) {
    XcdBarrier b; b.bar = bar; b.x = xb_xcc_id(); b.st = st;
    if (threadIdx.x == 0) (void)xb_add(&bar[XB_XCNT(b.x)], 1u);
    return b;
}
__device__ __forceinline__ void xcd_barrier_complete(unsigned* bar, unsigned x, unsigned& nloc, unsigned& nx) {
    const unsigned G = gridDim.x * gridDim.y * gridDim.z;
    unsigned sum, cnt, mine, sp = 0u;
    for (;;) {
        sum = 0u; cnt = 0u; mine = 0u;
#pragma unroll
        for (unsigned j = 0; j < 16; ++j) { const unsigned c = xb_ld(&bar[XB_XCNT(j)]); sum += c; cnt += (c > 0u) ? 1u : 0u; mine = (j == x) ? c : mine; }
        if (sum == G) break;
        __builtin_amdgcn_s_sleep(1);
        if ((++sp & 255u) == 0u) { if (xb_ld(&bar[XB_TMO])) break; if (sp > XB_SPIN_CAP) { atomicAdd(&bar[XB_TMO], 1u); break; } }
    }
    nloc = mine > 0u ? mine : 1u; nx = cnt > 0u ? cnt : 1u;
}

__device__ __forceinline__ void xcd_barrier(const XcdBarrier& b) {
    asm volatile("s_waitcnt vmcnt(0)" ::: "memory");
    __syncthreads();
    if (threadIdx.x == 0) {
        unsigned* bar = b.bar;
        __builtin_amdgcn_s_waitcnt(0);
        unsigned nloc = b.st[0], nx = b.st[1];
        if (nloc == 0u) { xcd_barrier_complete(bar, b.x, nloc, nx); b.st[0] = nloc; b.st[1] = nx; }
        const unsigned old = xb_add(&bar[XB_XSUB(b.x)], 1u);
        const unsigned gen = old / nloc;
        if (old + 1u == (gen + 1u) * nloc) {
            __builtin_amdgcn_fence(__ATOMIC_RELEASE, "agent");
            asm volatile("s_waitcnt vmcnt(0)" ::: "memory");
            const unsigned og = xb_add(&bar[XB_TOP], 1u);
            const unsigned tg = og / nx;
            if (og + 1u == (tg + 1u) * nx) xb_add(&bar[XB_TOPGEN], 1u);
            else XB_SPIN(xb_ld(&bar[XB_TOPGEN]) == tg, bar);
            __builtin_amdgcn_fence(__ATOMIC_ACQUIRE, "agent");
            xb_add(&bar[XB_XGEN(b.x)], 1u);
            asm volatile("s_waitcnt vmcnt(0)" ::: "memory");
        } else {
            XB_SPIN(xb_ld(&bar[XB_XGEN(b.x)]) == gen, bar);
            __builtin_amdgcn_fence(__ATOMIC_ACQUIRE, "agent");
            asm volatile("s_waitcnt vmcnt(0)" ::: "memory");
        }
    }
    __syncthreads();
}

struct Args { const float* in[22]; float* out; unsigned char* ws; int ph_lo, ph_hi, li, pad; };
enum { I_XP = 0, I_XS, I_CP, I_CS, I_SGLA, I_SK, I_SV, I_SCONV, I_WADA, I_BADA, I_GNORM, I_WIN, I_WAUP, I_BA, I_GGLA, I_SINK, I_WO, I_WUP, I_WCONV, I_BCONV, I_WDN, I_GFIN };

DI size_t wt_off(int nrow, int K, int k) {
    const int nl = nrow & 127, c = nl & 31, rho = 16 * ((c >> 2) & 1) + 4 * (c >> 3) + (c & 3);
    return ((size_t)(nrow >> 7) * (K >> 6) + (k >> 6)) * 16384 + pg8::lds_byte((nl & ~31) + rho, k & 63);
}
DI void tr_item(const float* __restrict__ W, int ldw, int k0, int nsrc0, int nvalid, bf16* __restrict__ WT, int ldt, int ndst0, LAS unsigned char* scr, int lane) {
    const int rg = lane >> 4, c4 = lane & 15;
    f32x4 v[4][4];
    const bool ok = (4 * c4) < nvalid;
#pragma unroll
    for (int kq = 0; kq < 4; ++kq)
#pragma unroll
        for (int j = 0; j < 4; ++j) {
            if (ok) v[kq][j] = *(const f32x4*)(W + (size_t)(k0 + 16 * kq + 4 * rg + j) * ldw + nsrc0 + 4 * c4);
            else v[kq][j] = (f32x4){0.f, 0.f, 0.f, 0.f};
        }
    const int x = 2 * (c4 & 7);
#pragma unroll
    for (int kq = 0; kq < 4; ++kq)
#pragma unroll
        for (int jn = 0; jn < 4; ++jn) {
            u32x2 w; w.x = pkbf(v[kq][0][jn], v[kq][1][jn]); w.y = pkbf(v[kq][2][jn], v[kq][3][jn]);
            const int g = 4 * kq + rg, n = 4 * c4 + jn;
            *(LAS u32x2*)(scr + n * 128 + ((g ^ x) * 8)) = w;
        }
    LDS_WAIT();
#pragma unroll
    for (int i = 0; i < 8; ++i) {
        const int n = (lane >> 3) + 8 * i, kc = lane & 7, xx = 2 * ((n >> 2) & 7);
        const u32x4 w = *(const LAS u32x4*)(scr + n * 128 + (((2 * kc) ^ xx) * 8));
        *(u32x4*)((unsigned char*)WT + wt_off(ndst0 + n, ldt, k0 + 8 * kc)) = w;
    }
    LDS_WAIT();
}
DI void tr_load(f32x4 (&v)[4][4], const float* __restrict__ W, int ldw, int k0, int nsrc0, int lane) {
    const int rg = lane >> 4, c4 = lane & 15;
#pragma unroll
    for (int kq = 0; kq < 4; ++kq)
#pragma unroll
        for (int j = 0; j < 4; ++j) v[kq][j] = *(const f32x4*)(W + (size_t)(k0 + 16 * kq + 4 * rg + j) * ldw + nsrc0 + 4 * c4);
}
DI void tr_emit(const f32x4 (&v)[4][4], bf16* __restrict__ WT, int ldt, int k0, int ndst0, LAS unsigned char* scr, int lane) {
    const int rg = lane >> 4, c4 = lane & 15, x = 2 * (c4 & 7);
#pragma unroll
    for (int kq = 0; kq < 4; ++kq)
#pragma unroll
        for (int jn = 0; jn < 4; ++jn) {
            u32x2 w; w.x = pkbf(v[kq][0][jn], v[kq][1][jn]); w.y = pkbf(v[kq][2][jn], v[kq][3][jn]);
            const int g = 4 * kq + rg, n = 4 * c4 + jn;
            *(LAS u32x2*)(scr + n * 128 + ((g ^ x) * 8)) = w;
        }
    LDS_WAIT();
#pragma unroll
    for (int i = 0; i < 8; ++i) {
        const int n = (lane >> 3) + 8 * i, kc = lane & 7, xx = 2 * ((n >> 2) & 7);
        const u32x4 w = *(const LAS u32x4*)(scr + n * 128 + (((2 * kc) ^ xx) * 8));
        *(u32x4*)((unsigned char*)WT + wt_off(ndst0 + n, ldt, k0 + 8 * kc)) = w;
    }
    LDS_WAIT();
}
DI void tr_plain2(const float* W, int K, int N, bf16* WT, int itA, int itB, LAS unsigned char* scr, int lane) {
    const int nb = N / 64, kA = itA / nb, nA = itA % nb, kB = itB / nb, nB = itB % nb;
    f32x4 va[4][4], vb[4][4];
    tr_load(va, W, N, 64 * kA, 64 * nA, lane); tr_load(vb, W, N, 64 * kB, 64 * nB, lane);
    tr_emit(va, WT, K, 64 * kA, 64 * nA, scr, lane); tr_emit(vb, WT, K, 64 * kB, 64 * nB, scr, lane);
}
DI void tr_wup2(const float* W, bf16* WT, int itA, int itB, LAS unsigned char* scr, int lane) {
    constexpr int nb = F2 / 64;
    const int kA = itA / nb, dA = itA % nb, kB = itB / nb, dB = itB % nb;
    const int sA = 64 * ((dA & 2) ? FF / 64 + 2 * (dA >> 2) + (dA & 1) : 2 * (dA >> 2) + (dA & 1)), sB = 64 * ((dB & 2) ? FF / 64 + 2 * (dB >> 2) + (dB & 1) : 2 * (dB >> 2) + (dB & 1));
    f32x4 va[4][4], vb[4][4];
    tr_load(va, W, F2, 64 * kA, sA, lane); tr_load(vb, W, F2, 64 * kB, sB, lane);
    tr_emit(va, WT, D, 64 * kA, 64 * dA, scr, lane); tr_emit(vb, WT, D, 64 * kB, 64 * dB, scr, lane);
}
DI void tr_plain(const float* W, int K, int N, bf16* WT, int it, LAS unsigned char* scr, int lane) {
    const int nb = N / 64, kb = it / nb, n = it % nb;
    tr_item(W, N, 64 * kb, 64 * n, 64, WT, K, 64 * n, scr, lane);
}
DI void tr_win(const float* W, bf16* WT, int it, LAS unsigned char* scr, int lane) {
    constexpr int nb = NINP / 64;
    const int kb = it / nb, n = it % nb;
    int nsrc0, nvalid;
    if (n < 96) { nsrc0 = 64 * n; nvalid = 64; }
    else if (n < 144) { nsrc0 = 64 * n + 16; nvalid = 64; }
    else if (n == 144) { nsrc0 = 6144; nvalid = 16; }
    else { nsrc0 = 0; nvalid = 0; }
    tr_item(W, NIN, 64 * kb, nsrc0, nvalid, WT, D, 64 * n, scr, lane);
}

constexpr int AD_CS_PITCH = 144, AD_CS_BYTES = 144 * AD_CS_PITCH, AD_IMG = 2 * AD_CS_BYTES, AD_IMG_PITCH = 144, AD_IMG_BYTES = 16 * AD_IMG_PITCH;
DI void adaln_block(int item0, const float* c_sample, const float* c_prompt, const float* W, const float* bias, float* MOD, LAS unsigned char* scr, int tid) {
    const int wave = tid >> 6, lane = tid & 63, l15 = lane & 15, quad = lane >> 4;
    const int n0 = 16 * (item0 + wave);
    LAS unsigned char* img = scr + AD_IMG + wave * AD_IMG_BYTES;
    for (int i = tid; i < 2 * 15 * (AD_CS_PITCH / 16); i += 512) { const int b = i / (15 * (AD_CS_PITCH / 16)), j = i % (15 * (AD_CS_PITCH / 16));
        *(LAS u32x4*)(scr + b * AD_CS_BYTES + 129 * AD_CS_PITCH + j * 16) = (u32x4){0u, 0u, 0u, 0u}; }
    f32x4 acc[9];
#pragma unroll
    for (int m = 0; m < 9; ++m) acc[m] = (f32x4){0.f, 0.f, 0.f, 0.f};
    const int rg = lane >> 2, c4 = lane & 3;
    const float* wp = W + (size_t)(4 * rg) * NMOD + n0 + 4 * c4;
    f32x4 wa[4], wb[4];
#pragma unroll
    for (int j = 0; j < 4; ++j) { wa[j] = __builtin_nontemporal_load((const f32x4*)(wp + (size_t)j * NMOD)); wb[j] = __builtin_nontemporal_load((const f32x4*)(wp + (size_t)(64 + j) * NMOD)); }
    f32x4 cv[5];
#define AD_CLOAD(s) do { _Pragma("unroll") for (int t = 0; t < 5; ++t) { int i = tid + 512 * t; i = i < 129 * 16 ? i : 129 * 16 - 1; const int m = i >> 4, q = i & 15; \
        cv[t] = *(const f32x4*)((m < 128 ? c_sample + (size_t)m * D : c_prompt) + 64 * (s) + 4 * q); } } while (0)
#define AD_CSTORE(buf) do { _Pragma("unroll") for (int t = 0; t < 5; ++t) { const int i = tid + 512 * t; const int m = i >> 4, q = i & 15; \
        u32x2 w; w.x = pkbf(silu_f(cv[t].x), silu_f(cv[t].y)); w.y = pkbf(silu_f(cv[t].z), silu_f(cv[t].w)); \
        if (i < 129 * 16) *(LAS u32x2*)((buf) + m * AD_CS_PITCH + q * 8) = w; } } while (0)
    AD_CLOAD(0); AD_CSTORE(scr);
    __syncthreads();
#define AD_STEP(wc, kblk) do { \
        const LAS unsigned char* abuf = scr + ((kblk) & 1) * AD_CS_BYTES; \
        { const int sn = (kblk) + 1 < 64 ? (kblk) + 1 : 63; AD_CLOAD(sn); }     \
        _Pragma("unroll") for (int jn = 0; jn < 4; ++jn) { u32x2 w; w.x = pkbf(wc[0][jn], wc[1][jn]); w.y = pkbf(wc[2][jn], wc[3][jn]); *(LAS u32x2*)(img + (4 * c4 + jn) * AD_IMG_PITCH + rg * 8) = w; } \
        { const int kn = (kblk) + 2 < 64 ? (kblk) + 2 : 63;                    \
          _Pragma("unroll") for (int j = 0; j < 4; ++j) wc[j] = __builtin_nontemporal_load((const f32x4*)(wp + (size_t)(64 * kn + j) * NMOD)); } \
        bf16x8 af[18];                                                         \
        _Pragma("unroll") for (int m = 0; m < 9; ++m) { const LAS unsigned char* ap = abuf + (16 * m + l15) * AD_CS_PITCH + (8 * quad) * 2; af[2 * m] = *(const LAS bf16x8*)ap; af[2 * m + 1] = *(const LAS bf16x8*)(ap + 64); } \
        const bf16x8 b0 = *(const LAS bf16x8*)(img + l15 * AD_IMG_PITCH + (8 * quad) * 2), b1 = *(const LAS bf16x8*)(img + l15 * AD_IMG_PITCH + (32 + 8 * quad) * 2); \
        __builtin_amdgcn_sched_barrier(0); \
        _Pragma("unroll") for (int m = 0; m < 9; ++m) acc[m] = MFMA16(af[2 * m], b0, acc[m]); \
        _Pragma("unroll") for (int m = 0; m < 9; ++m) acc[m] = MFMA16(af[2 * m + 1], b1, acc[m]); \
        __builtin_amdgcn_sched_barrier(0); \
        AD_CSTORE(scr + (((kblk) + 1) & 1) * AD_CS_BYTES);                     \
        __syncthreads(); } while (0)
#pragma unroll 1
    for (int kb2 = 0; kb2 < 64; kb2 += 2) { AD_STEP(wa, kb2); AD_STEP(wb, kb2 + 1); }
#undef AD_STEP
#undef AD_CLOAD
#undef AD_CSTORE
    const float bv = bias[n0 + l15];
#pragma unroll
    for (int m = 0; m < 9; ++m)
#pragma unroll
        for (int r = 0; r < 4; ++r) { const int row = 16 * m + 4 * quad + r; if (row <= 128) MOD[(size_t)row * NMOD + n0 + l15] = acc[m][r] + bv; }
    __syncthreads();
}

DI f32x4 ld4(const float* p) { return *(const f32x4*)p; }
DI f32x4 ld4(const bf16* p) { const u32x2 w = *(const u32x2*)p; return (f32x4){bflo(w.x), bfhi(w.x), bflo(w.y), bfhi(w.y)}; }
template <int MODE, class T>
DI void sample_pair(int pr, const T* base, const float* MOD, int gate_off, const bf16* SLAB, bf16* xout, const float* g, int sc_off, int sh_off, bf16* Hs, float* outY, LAS float* red, int tid) {
    constexpr bool SLABS = MODE != 0, FINAL = MODE == 2;
    const int wave = tid >> 6, lane = tid & 63, r = 2 * pr + (wave >> 2), c0 = 1024 * (wave & 3) + 4 * lane;
    const float* m = MOD + (size_t)(r >> 2) * NMOD;
    const size_t ro = (size_t)r * D;
    f32x4 s[4], xb[4], gt[4];
#pragma unroll
    for (int j = 0; j < 4; ++j) { const int c = c0 + 256 * j; xb[j] = ld4(base + ro + c); if (SLABS) { s[j] = ld4(SLAB + ro + c); gt[j] = *(const f32x4*)(m + gate_off + c); } }
#pragma unroll
    for (int ks = 1; ks < (SLABS ? 8 : 1); ++ks)
#pragma unroll
        for (int j = 0; j < 4; ++j) s[j] += ld4(SLAB + (size_t)ks * 512 * 4096 + ro + c0 + 256 * j);
    float ss = 0.f;
#pragma unroll
    for (int j = 0; j < 4; ++j) {
        f32x4 v = xb[j];
        if (SLABS) v += gt[j] * s[j];
        if (MODE == 1) { u32x2 w; w.x = pkbf(v.x, v.y); w.y = pkbf(v.z, v.w); *(u32x2*)(xout + ro + c0 + 256 * j) = w; v = (f32x4){bflo(w.x), bfhi(w.x), bflo(w.y), bfhi(w.y)}; }
        s[j] = v; ss += (v.x * v.x + v.y * v.y) + (v.z * v.z + v.w * v.w);
    }
    ss = wave_sum(ss);
    if (lane == 0) red[wave] = ss;
    __syncthreads();
    const int w4 = wave & ~3;
    const float rstd = 1.0f / sqrtf(((red[w4] + red[w4 + 1]) + (red[w4 + 2] + red[w4 + 3])) * (1.0f / D) + NORM_EPS);
#pragma unroll
    for (int j = 0; j < 4; ++j) { const int c = c0 + 256 * j;
        if (FINAL) *(f32x4*)(outY + ro + c) = (s[j] * rstd) * *(const f32x4*)(g + c);
        else { const f32x4 o = (s[j] * rstd) * *(const f32x4*)(g + c) * (*(const f32x4*)(m + sc_off + c) + 1.0f) + *(const f32x4*)(m + sh_off + c);
            u32x2 w; w.x = pkbf(o.x, o.y); w.y = pkbf(o.z, o.w); *(u32x2*)(Hs + ro + c) = w; }
    }
    __syncthreads();
}
DI void modnorm_row(const float* xrow, const float* g, const float* sc, const float* sh, bf16* orow, int lane) {
    f32x4 v[16]; float s = 0.f;
#pragma unroll
    for (int j = 0; j < 16; ++j) { v[j] = *(const f32x4*)(xrow + 4 * (lane + 64 * j)); s += (v[j].x * v[j].x + v[j].y * v[j].y) + (v[j].z * v[j].z + v[j].w * v[j].w); }
    const float rstd = 1.0f / sqrtf(wave_sum(s) * (1.0f / D) + NORM_EPS);
#pragma unroll
    for (int j = 0; j < 16; ++j) {
        const int c = 4 * (lane + 64 * j);
        const f32x4 gv = *(const f32x4*)(g + c), sv = *(const f32x4*)(sc + c), hv = *(const f32x4*)(sh + c);
        const f32x4 o = (v[j] * rstd) * gv * (sv + 1.0f) + hv;
        u32x2 w; w.x = pkbf(o.x, o.y); w.y = pkbf(o.z, o.w);
        *(u32x2*)(orow + c) = w;
    }
}
DI void load_row_bf(f32x4 (&v)[16], const bf16* xrow, int lane) {
#pragma unroll
    for (int j = 0; j < 8; ++j) { const u32x4 w = *(const u32x4*)(xrow + 8 * (lane + 64 * j));
        v[2 * j] = (f32x4){bflo(w.x), bfhi(w.x), bflo(w.y), bfhi(w.y)}; v[2 * j + 1] = (f32x4){bflo(w.z), bfhi(w.z), bflo(w.w), bfhi(w.w)}; }
}
DI void modnorm_row(const bf16* xrow, const float* g, const float* sc, const float* sh, bf16* orow, int lane) {
    f32x4 v[16]; float s = 0.f;
    load_row_bf(v, xrow, lane);
#pragma unroll
    for (int j = 0; j < 16; ++j) s += (v[j].x * v[j].x + v[j].y * v[j].y) + (v[j].z * v[j].z + v[j].w * v[j].w);
    const float rstd = 1.0f / sqrtf(wave_sum(s) * (1.0f / D) + NORM_EPS);
#pragma unroll
    for (int j = 0; j < 8; ++j) {
        const int c = 8 * (lane + 64 * j);
        u32x4 w; unsigned* wp = (unsigned*)&w;
#pragma unroll
        for (int hh = 0; hh < 2; ++hh) {
            const f32x4 gv = *(const f32x4*)(g + c + 4 * hh), sv = *(const f32x4*)(sc + c + 4 * hh), hv = *(const f32x4*)(sh + c + 4 * hh);
            const f32x4 o = (v[2 * j + hh] * rstd) * gv * (sv + 1.0f) + hv;
            wp[2 * hh] = pkbf(o.x, o.y); wp[2 * hh + 1] = pkbf(o.z, o.w);
        }
        *(u32x4*)(orow + c) = w;
    }
}
DI void finalnorm_row(const bf16* xrow, float* orow, const float* g, int lane) {
    f32x4 v[16]; float s = 0.f;
    load_row_bf(v, xrow, lane);
#pragma unroll
    for (int j = 0; j < 16; ++j) s += (v[j].x * v[j].x + v[j].y * v[j].y) + (v[j].z * v[j].z + v[j].w * v[j].w);
    const float rstd = 1.0f / sqrtf(wave_sum(s) * (1.0f / D) + NORM_EPS);
#pragma unroll
    for (int j = 0; j < 8; ++j) { const int c = 8 * (lane + 64 * j);
        *(f32x4*)(orow + c) = (v[2 * j] * rstd) * *(const f32x4*)(g + c); *(f32x4*)(orow + c + 4) = (v[2 * j + 1] * rstd) * *(const f32x4*)(g + c + 4); }
}

constexpr int KS_PITCH = 272, VT_PITCH = 528, SWA_KS_OFF = 0, SWA_VT_OFF = 256 * KS_PITCH;
template <int NDM>
DI void swa_group(const LAS unsigned char* Ks, const LAS unsigned char* Vt, const bf16* qptr, int ts, int ie, int kmin, float slope, float sink, int dbase, bf16* optr, int lane) {
    const int l15 = lane & 15, quad = lane >> 4;
    bf16x8 bq[4];
#pragma unroll
    for (int s = 0; s < 4; ++s) bq[s] = *(const bf16x8*)(qptr + 32 * s + 8 * quad);
    f32x4 sc[10];
#pragma unroll
    for (int kt = 0; kt < 10; ++kt) sc[kt] = (f32x4){0.f, 0.f, 0.f, 0.f};
#define SW_SB() __builtin_amdgcn_sched_barrier(0)
#define SW_LK(f, p) do { _Pragma("unroll") for (int i = 0; i < 8; ++i) f[i] = *(const LAS bf16x8*)(Ks + (16 * (ts + 2 * (p) + (i >> 2)) + l15) * KS_PITCH + (32 * (i & 3) + 8 * quad) * 2); } while (0)
#define SW_MK(f, p) do { _Pragma("unroll") for (int i = 0; i < 8; ++i) sc[2 * (p) + (i >> 2)] = MFMA16(f[i], bq[i & 3], sc[2 * (p) + (i >> 2)]); } while (0)
    {
        bf16x8 ka[8], kb[8];
        SW_LK(ka, 0); SW_LK(kb, 1);
        SW_SB(); SW_MK(ka, 0); SW_SB(); SW_LK(ka, 2);
        SW_SB(); SW_MK(kb, 1); SW_SB(); SW_LK(kb, 3);
        SW_SB(); SW_MK(ka, 2); SW_SB(); SW_LK(ka, 4);
        SW_SB(); SW_MK(kb, 3);
        SW_SB(); SW_MK(ka, 4); SW_SB();
    }
    float mx = sink;
#pragma unroll
    for (int kt = 0; kt < 10; ++kt)
#pragma unroll
        for (int r = 0; r < 4; ++r) {
            const int key = 16 * (ts + kt) + 4 * quad + r, dd = 128 + ie - key;
            const bool valid = (dd >= 0) && (dd <= 128) && (key >= kmin);
            const float sv = valid ? (sc[kt][r] * 0.08838834764831845f - slope * (float)dd) : -1e30f;
            sc[kt][r] = sv; mx = fmaxf(mx, sv);
        }
    mx = fmaxf(mx, __shfl_xor(mx, 16)); mx = fmaxf(mx, __shfl_xor(mx, 32));
    float sum = 0.f;
#pragma unroll
    for (int kt = 0; kt < 10; ++kt)
#pragma unroll
        for (int r = 0; r < 4; ++r) { const float p = __expf(sc[kt][r] - mx); sc[kt][r] = p; sum += p; }
    sum += __shfl_xor(sum, 16); sum += __shfl_xor(sum, 32);
    sum += __expf(sink - mx);
    const float inv = 1.0f / sum;
    f32x4 o[NDM];
#pragma unroll
    for (int dm = 0; dm < NDM; ++dm) o[dm] = (f32x4){0.f, 0.f, 0.f, 0.f};
#define SW_LV(f, st) do { _Pragma("unroll") for (int dm = 0; dm < NDM; ++dm) { const LAS unsigned char* vp = Vt + (dbase + 16 * dm + l15) * VT_PITCH + (16 * (ts + 2 * (st)) + 4 * quad) * 2; \
        const bf16x4 lo = *(const LAS bf16x4*)vp, hi = *(const LAS bf16x4*)(vp + 32); f[dm] = __builtin_shufflevector(lo, hi, 0, 1, 2, 3, 4, 5, 6, 7); } } while (0)
#define SW_MV(f, st) do { u32x4 pw; pw.x = pkbf(sc[2 * (st)][0], sc[2 * (st)][1]); pw.y = pkbf(sc[2 * (st)][2], sc[2 * (st)][3]); pw.z = pkbf(sc[2 * (st) + 1][0], sc[2 * (st) + 1][1]); pw.w = pkbf(sc[2 * (st) + 1][2], sc[2 * (st) + 1][3]); \
        const bf16x8 bp = __builtin_bit_cast(bf16x8, pw); _Pragma("unroll") for (int dm = 0; dm < NDM; ++dm) o[dm] = MFMA16(f[dm], bp, o[dm]); } while (0)
    {
        bf16x8 va[NDM], vb[NDM];
        SW_LV(va, 0); SW_LV(vb, 1);
        SW_SB(); SW_MV(va, 0); SW_SB(); SW_LV(va, 2);
        SW_SB(); SW_MV(vb, 1); SW_SB(); SW_LV(vb, 3);
        SW_SB(); SW_MV(va, 2); SW_SB(); SW_LV(va, 4);
        SW_SB(); SW_MV(vb, 3);
        SW_SB(); SW_MV(va, 4); SW_SB();
    }
#undef SW_SB
#undef SW_LK
#undef SW_MK
#undef SW_LV
#undef SW_MV
#pragma unroll
    for (int dm = 0; dm < NDM; ++dm) {
        u32x2 w; w.x = pkbf(o[dm][0] * inv, o[dm][1] * inv); w.y = pkbf(o[dm][2] * inv, o[dm][3] * inv);
        *(u32x2*)(optr + 16 * dm + 4 * quad) = w;
    }
}
DI float alibi_slope(int head) { return exp2f(-0.5f * (float)(head + 1)); }
DI f32x4 bf4lo(const u32x4 w) { return (f32x4){bflo(w.x), bfhi(w.x), bflo(w.y), bfhi(w.y)}; }
DI f32x4 bf4hi(const u32x4 w) { return (f32x4){bflo(w.z), bfhi(w.z), bflo(w.w), bfhi(w.w)}; }
DI void vt_store(LAS unsigned char* Vt, int c, int j0, const u32x4 w0, const u32x4 w1) {
    LAS unsigned char* vb = Vt + (8 * c) * VT_PITCH + j0 * 2;
    *(LAS unsigned*)(vb + 0 * VT_PITCH) = (w0.x & 0xffffu) | (w1.x << 16);
    *(LAS unsigned*)(vb + 1 * VT_PITCH) = (w0.x >> 16) | (w1.x & 0xffff0000u);
    *(LAS unsigned*)(vb + 2 * VT_PITCH) = (w0.y & 0xffffu) | (w1.y << 16);
    *(LAS unsigned*)(vb + 3 * VT_PITCH) = (w0.y >> 16) | (w1.y & 0xffff0000u);
    *(LAS unsigned*)(vb + 4 * VT_PITCH) = (w0.z & 0xffffu) | (w1.z << 16);
    *(LAS unsigned*)(vb + 5 * VT_PITCH) = (w0.z >> 16) | (w1.z & 0xffff0000u);
    *(LAS unsigned*)(vb + 6 * VT_PITCH) = (w0.w & 0xffffu) | (w1.w << 16);
    *(LAS unsigned*)(vb + 7 * VT_PITCH) = (w0.w >> 16) | (w1.w & 0xffff0000u);
}

DI void swa_prompt_unit(int qb, int kvh, const bf16* PROJ, const float* sinks, bf16* MIX, float* outK, float* outV, LAS unsigned char* scr, int tid) {
    LAS unsigned char* Ks = scr + SWA_KS_OFF; LAS unsigned char* Vt = scr + SWA_VT_OFF;
    const int pos_base = 128 * (qb - 1);
    {
        u32x4 kw[8];
#pragma unroll
        for (int it = 0; it < 8; ++it) {
            const int ch = tid + 512 * it, j = ch >> 4, c = ch & 15, pos = pos_base + j;
            kw[it] = (u32x4){0u, 0u, 0u, 0u};
            if (pos >= 0) kw[it] = *(const u32x4*)(PROJ + (size_t)pos * NINP + PC_SK + kvh * 128 + 8 * c);
        }
#pragma unroll
        for (int it = 0; it < 8; ++it) { const int ch = tid + 512 * it; *(LAS u32x4*)(Ks + (ch >> 4) * KS_PITCH + (ch & 15) * 16) = kw[it]; }
    }
    {
        u32x4 vw[8];
#pragma unroll
        for (int it = 0; it < 4; ++it) {
            const int jp = tid & 127, c = (tid >> 7) + 4 * it, pos0 = pos_base + 2 * jp;
            vw[2 * it] = (u32x4){0u, 0u, 0u, 0u}; vw[2 * it + 1] = vw[2 * it];
            if (pos0 >= 0) { const bf16* p = PROJ + (size_t)pos0 * NINP + PC_SV + kvh * 128 + 8 * c; vw[2 * it] = *(const u32x4*)p; vw[2 * it + 1] = *(const u32x4*)(p + NINP); }
        }
#pragma unroll
        for (int it = 0; it < 4; ++it) vt_store(Vt, (tid >> 7) + 4 * it, 2 * (tid & 127), vw[2 * it], vw[2 * it + 1]);
    }
    if (qb == 63) {
#pragma unroll 1
        for (int ch = tid; ch < 2 * 128 * 16; ch += 512) {
            const int kv = ch >> 11, j = (ch >> 4) & 127, c = ch & 15;
            const u32x4 w = *(const u32x4*)(PROJ + (size_t)(TP - 128 + j) * NINP + (kv ? PC_SV : PC_SK) + kvh * 128 + 8 * c);
            float* o = (kv ? outV : outK) + (size_t)j * 512 + kvh * 128 + 8 * c; *(f32x4*)o = bf4lo(w); *(f32x4*)(o + 4) = bf4hi(w);
        }
    }
    __syncthreads();
    const int wave = tid >> 6, lane = tid & 63, l15 = lane & 15;
    const int g = wave >> 1, head = kvh * 4 + g;
    const float slope = alibi_slope(head), sink = sinks[head];
#pragma unroll 1
    for (int q4 = 0; q4 < 4; ++q4) {
        const int i0 = 64 * (wave & 1) + 16 * q4, ts = (i0 >> 4) < 6 ? (i0 >> 4) : 6;
        const size_t row = (size_t)128 * qb + i0 + l15;
        swa_group<8>(Ks, Vt, PROJ + row * NINP + PC_SQ + head * 128, ts, i0 + l15, qb == 0 ? 128 : 0, slope, sink, 0, MIX + row * D + 2048 + head * 128, lane);
    }
    __syncthreads();
}
DI void swa_sample_unit(int b, int kvh, const bf16* PROJ, const float* stK, const float* stV, const float* sinks, bf16* MIX, float* outK, float* outV, LAS unsigned char* scr, int tid) {
    LAS unsigned char* Ks = scr + SWA_KS_OFF; LAS unsigned char* Vt = scr + SWA_VT_OFF;
    const size_t sbase = (size_t)b * 128 * 512 + kvh * 128;
    const size_t prow = (size_t)(TP + 4 * b);
    {
        f32x4 ka[4], kb[4];
#pragma unroll
        for (int it = 0; it < 4; ++it) { const int ch = tid + 512 * it; const float* p = stK + sbase + (size_t)(ch >> 4) * 512 + 8 * (ch & 15); ka[it] = __builtin_nontemporal_load((const f32x4*)p); kb[it] = __builtin_nontemporal_load((const f32x4*)(p + 4)); }
        f32x4 va[2][4];
#pragma unroll
        for (int it = 0; it < 2; ++it) { const int jp = tid & 63, c = (tid >> 6) + 8 * it; const float* p = stV + sbase + (size_t)(2 * jp) * 512 + 8 * c;
            va[it][0] = __builtin_nontemporal_load((const f32x4*)p); va[it][1] = __builtin_nontemporal_load((const f32x4*)(p + 4)); va[it][2] = __builtin_nontemporal_load((const f32x4*)(p + 512)); va[it][3] = __builtin_nontemporal_load((const f32x4*)(p + 516)); }
#pragma unroll
        for (int it = 0; it < 4; ++it) {
            const int ch = tid + 512 * it, j = ch >> 4, c = ch & 15;
            u32x4 w; w.x = pkbf(ka[it].x, ka[it].y); w.y = pkbf(ka[it].z, ka[it].w); w.z = pkbf(kb[it].x, kb[it].y); w.w = pkbf(kb[it].z, kb[it].w);
            *(LAS u32x4*)(Ks + j * KS_PITCH + c * 16) = w;
            if (j >= 4) { float* o = outK + sbase + (size_t)(j - 4) * 512 + 8 * c; *(f32x4*)o = ka[it]; *(f32x4*)(o + 4) = kb[it]; }
        }
#pragma unroll
        for (int it = 0; it < 2; ++it) {
            const int jp = tid & 63, c = (tid >> 6) + 8 * it, j0 = 2 * jp;
            u32x4 w0, w1;
            w0.x = pkbf(va[it][0].x, va[it][0].y); w0.y = pkbf(va[it][0].z, va[it][0].w); w0.z = pkbf(va[it][1].x, va[it][1].y); w0.w = pkbf(va[it][1].z, va[it][1].w);
            w1.x = pkbf(va[it][2].x, va[it][2].y); w1.y = pkbf(va[it][2].z, va[it][2].w); w1.z = pkbf(va[it][3].x, va[it][3].y); w1.w = pkbf(va[it][3].z, va[it][3].w);
            vt_store(Vt, c, j0, w0, w1);
            if (j0 >= 4) { float* o = outV + sbase + (size_t)(j0 - 4) * 512 + 8 * c; *(f32x4*)o = va[it][0]; *(f32x4*)(o + 4) = va[it][1]; *(f32x4*)(o + 512) = va[it][2]; *(f32x4*)(o + 516) = va[it][3]; }
        }
    }
    {
        const int j = 128 + (tid >> 4), c = tid & 15;
        u32x4 w = (u32x4){0u, 0u, 0u, 0u};
        if (j < 132) {
            w = *(const u32x4*)(PROJ + (prow + (j - 128)) * NINP + PC_SK + kvh * 128 + 8 * c);
            float* o = outK + sbase + (size_t)(j - 4) * 512 + 8 * c; *(f32x4*)o = bf4lo(w); *(f32x4*)(o + 4) = bf4hi(w);
        }
        *(LAS u32x4*)(Ks + j * KS_PITCH + c * 16) = w;
        if (tid < 256) {
            const int jp = 64 + (tid & 15), cv = tid >> 4, j0 = 2 * jp;
            u32x4 w0 = (u32x4){0u, 0u, 0u, 0u}, w1 = w0;
            if (j0 < 132) {
                const bf16* p = PROJ + (prow + (j0 - 128)) * NINP + PC_SV + kvh * 128 + 8 * cv; w0 = *(const u32x4*)p; w1 = *(const u32x4*)(p + NINP);
                float* o = outV + sbase + (size_t)(j0 - 4) * 512 + 8 * cv;
                *(f32x4*)o = bf4lo(w0); *(f32x4*)(o + 4) = bf4hi(w0); *(f32x4*)(o + 512) = bf4lo(w1); *(f32x4*)(o + 516) = bf4hi(w1);
            }
            vt_store(Vt, cv, j0, w0, w1);
        }
    }
    __syncthreads();
    const int wave = tid >> 6, lane = tid & 63, l15 = lane & 15;
    const int g = l15 >> 2, t = l15 & 3, head = kvh * 4 + g;
    const size_t row = prow + t;
    swa_group<1>(Ks, Vt, PROJ + row * NINP + PC_SQ + head * 128, 0, t, 0, alibi_slope(head), sinks[head], 16 * wave, MIX + row * D + 2048 + head * 128 + 16 * wave, lane);
    __syncthreads();
}

constexpr int CHK_BYTES = 66560;
constexpr int GL_GA = 0, GL_PART = 4096, GL_QG = 6144, GL_KG = 6144 + 33792, GL_VTF = 6144 + 2 * 33792, GL_AM = GL_QG, GL_PITCH = 528, AM_PITCH = 144;
DI void gla_local_unit(int n, int h, const bf16* PROJ, const float* w_a_up, const float* b_a, unsigned char* CHK, unsigned char* VTF, bf16* OIA, LAS unsigned char* scr, int tid, int stop) {
    const size_t row0 = (size_t)64 * n, hn = (size_t)h * 128 + n;
    const int wave = tid >> 6, lane = tid & 63, l15 = lane & 15, quad = lane >> 4;
    LAS float* gaS = (LAS float*)(scr + GL_GA); LAS float* partS = (LAS float*)(scr + GL_PART);
    LAS float* ZS = (LAS float*)(scr + GL_VTF);
    for (int idx = tid; idx < 1024; idx += 512) gaS[idx] = bf2f(PROJ[(row0 + (idx >> 4)) * NINP + PC_GA + (idx & 15)]);
    u32x4 wv[8];
    {
        const bf16* vp = PROJ + row0 * NINP + PC_GV + h * 512 + tid;
#pragma unroll
        for (int g8 = 0; g8 < 8; ++g8) {
            unsigned e[8];
#pragma unroll
            for (int j = 0; j < 8; ++j) e[j] = vp[(size_t)(8 * g8 + j) * NINP];
            wv[g8].x = e[0] | (e[1] << 16); wv[g8].y = e[2] | (e[3] << 16); wv[g8].z = e[4] | (e[5] << 16); wv[g8].w = e[6] | (e[7] << 16);
        }
    }
    float wb[2][4];
#pragma unroll
    for (int nt = 0; nt < 2; ++nt)
#pragma unroll
        for (int s = 0; s < 4; ++s) wb[nt][s] = w_a_up[(4 * s + quad) * 1024 + h * 256 + 32 * wave + 16 * nt + l15];
    const float bz0 = b_a[h * 256 + 32 * wave + l15], bz1 = b_a[h * 256 + 32 * wave + 16 + l15];
    __syncthreads();
    if (stop == 1) return;
#pragma unroll
    for (int mt = 0; mt < 4; ++mt) {
        f32x4 z0 = (f32x4){bz0, bz0, bz0, bz0}, z1 = (f32x4){bz1, bz1, bz1, bz1};
#pragma unroll
        for (int s = 0; s < 4; ++s) { const float a = gaS[(16 * mt + l15) * 16 + 4 * s + quad];
            z0 = __builtin_amdgcn_mfma_f32_16x16x4f32(a, wb[0][s], z0, 0, 0, 0); z1 = __builtin_amdgcn_mfma_f32_16x16x4f32(a, wb[1][s], z1, 0, 0, 0); }
#pragma unroll
        for (int r = 0; r < 4; ++r) { ZS[(16 * mt + 4 * quad + r) * 256 + 32 * wave + l15] = z0[r]; ZS[(16 * mt + 4 * quad + r) * 256 + 32 * wave + 16 + l15] = z1[r]; }
    }
    __syncthreads();
    const int k = tid & 255, half = tid >> 8, col = h * 256 + k;
    {
        float s = 0.f;
#pragma unroll 8
        for (int t = 32 * half; t < 32 * half + 32; ++t) { const float la = logsig16(ZS[t * 256 + k]); ZS[t * 256 + k] = la; s += la; }
        partS[half * 256 + k] = s;
    }
    __syncthreads();
    if (stop == 2) return;
    {
        const float p0 = partS[k], p1 = partS[256 + k], blast = p0 + p1;
        float bc = half ? p0 : 0.f;
        const float dec = __expf(blast);
        if (half == 0) *(float*)(CHK + hn * CHK_BYTES + 65536 + k * 4) = dec;
        const bf16* qp = PROJ + (row0 + 32 * half) * NINP + PC_GQ + col; const bf16* kp = PROJ + (row0 + 32 * half) * NINP + PC_GK + col;
        unsigned qk[32];
#pragma unroll
        for (int t = 0; t < 32; ++t) qk[t] = (unsigned)qp[(size_t)t * NINP] | ((unsigned)kp[(size_t)t * NINP] << 16);
        u32x4 kdw[4];
#pragma unroll
        for (int q4 = 0; q4 < 4; ++q4) {
            float kd[8];
#pragma unroll
            for (int j = 0; j < 8; ++j) {
                const int t = 32 * half + 8 * q4 + j;
                bc += ZS[t * 256 + k];
                const float qv = bflo(qk[8 * q4 + j]) * 0.0625f, kv = bfhi(qk[8 * q4 + j]);
                const float eb = __expf(bc), qg = qv * eb, kg = kv * __builtin_amdgcn_rcpf(eb);
                kd[j] = kg * dec;
                *(LAS bf16*)(scr + GL_QG + t * GL_PITCH + k * 2) = (bf16)(pkbf(qg, 0.f) & 0xffffu);
                *(LAS bf16*)(scr + GL_KG + t * GL_PITCH + k * 2) = (bf16)(pkbf(kg, 0.f) & 0xffffu);
            }
            kdw[q4].x = pkbf(kd[0], kd[1]); kdw[q4].y = pkbf(kd[2], kd[3]); kdw[q4].z = pkbf(kd[4], kd[5]); kdw[q4].w = pkbf(kd[6], kd[7]);
        }
#pragma unroll
        for (int q4 = 0; q4 < 4; ++q4) {
            const int off = ((((k >> 4) * 2 + half) * 64) + q4 * 16 + (k & 15)) * 16;
            *(u32x4*)(CHK + hn * CHK_BYTES + 32768 + off) = kdw[q4];
        }
    }
    __syncthreads();
    if (stop == 3) return;
#pragma unroll
    for (int g8 = 0; g8 < 8; ++g8) {
        const int off = ((((tid >> 4) * 2 + (g8 >> 2)) * 64) + (g8 & 3) * 16 + (tid & 15)) * 16;
        *(LAS u32x4*)(scr + GL_VTF + off) = wv[g8];
        *(u32x4*)(VTF + hn * 65536 + off) = wv[g8];
    }
#pragma unroll
    for (int i = 0; i < 4; ++i) {
        const int f = tid + 512 * i, frag = f >> 6, ln = f & 63, fl = ln & 15, fq = ln >> 4, mt = frag >> 3, st = frag & 7, t = 16 * mt + fl;
        const u32x2 lo = *(const LAS u32x2*)(scr + GL_QG + t * GL_PITCH + (32 * st + 4 * fq) * 2), hi = *(const LAS u32x2*)(scr + GL_QG + t * GL_PITCH + (32 * st + 16 + 4 * fq) * 2);
        *(u32x4*)(CHK + hn * CHK_BYTES + (size_t)f * 16) = (u32x4){lo.x, lo.y, hi.x, hi.y};
    }
    f32x4 a0 = (f32x4){0.f, 0.f, 0.f, 0.f}, a1 = a0;
    const int mt = wave >> 1, nt0 = 2 * (wave & 1);
#pragma unroll
    for (int st = 0; st < 8; ++st) {
        const bf16x8 a = *(const LAS bf16x8*)(scr + GL_QG + (16 * mt + l15) * GL_PITCH + (32 * st + 8 * quad) * 2);
        const bf16x8 b0 = *(const LAS bf16x8*)(scr + GL_KG + (16 * nt0 + l15) * GL_PITCH + (32 * st + 8 * quad) * 2);
        const bf16x8 b1 = *(const LAS bf16x8*)(scr + GL_KG + (16 * (nt0 + 1) + l15) * GL_PITCH + (32 * st + 8 * quad) * 2);
        a0 = MFMA16(a, b0, a0); a1 = MFMA16(a, b1, a1);
    }
    __syncthreads();
    if (stop == 4) return;
#pragma unroll
    for (int r = 0; r < 4; ++r) {
        const int t = 16 * mt + 4 * quad + r, s0 = 16 * nt0 + l15, s1 = s0 + 16;
        *(LAS bf16*)(scr + GL_AM + t * AM_PITCH + s0 * 2) = (bf16)(pkbf(s0 <= t ? a0[r] : 0.f, 0.f) & 0xffffu);
        *(LAS bf16*)(scr + GL_AM + t * AM_PITCH + s1 * 2) = (bf16)(pkbf(s1 <= t ? a1[r] : 0.f, 0.f) & 0xffffu);
    }
    __syncthreads();
    for (int vti = 0; vti < 4; ++vti) {
        const int vt = 4 * wave + vti;
        const bf16x8 b0 = *(const LAS bf16x8*)(scr + GL_VTF + ((vt * 2 + 0) * 64 + lane) * 16), b1 = *(const LAS bf16x8*)(scr + GL_VTF + ((vt * 2 + 1) * 64 + lane) * 16);
#pragma unroll
        for (int m2 = 0; m2 < 4; ++m2) {
            const bf16x8 x0 = *(const LAS bf16x8*)(scr + GL_AM + (16 * m2 + l15) * AM_PITCH + (8 * quad) * 2), x1 = *(const LAS bf16x8*)(scr + GL_AM + (16 * m2 + l15) * AM_PITCH + (32 + 8 * quad) * 2);
            f32x4 acc = (f32x4){0.f, 0.f, 0.f, 0.f};
            acc = MFMA16(b0, x0, acc); acc = MFMA16(b1, x1, acc);
            u32x2 w; w.x = pkbf(acc[0], acc[1]); w.y = pkbf(acc[2], acc[3]);
            *(u32x2*)(OIA + (row0 + 16 * m2 + l15) * 2048 + h * 512 + 16 * vt + 4 * quad) = w;
        }
    }
    __syncthreads();
}

constexpr int SC_KD = 0, SC_DEC = 32768, SC_VT = 33792, SC_BUF = 35840;
constexpr int SC_NP = SC_BUF / 16, SC_NC = (32768 + 1024) / 16;
DI u32x4 gload16(const unsigned char* p) { u32x4 r; asm volatile("global_load_dwordx4 %0, %1, off" : "=v"(r) : "v"(p) : "memory"); return r; }
DI void scan_issue(u32x4 (&r)[5], const unsigned char* CHK, const unsigned char* VTF, size_t hn, int c, int lt) {
    const unsigned char* a = CHK + hn * CHK_BYTES + 32768; const unsigned char* b = VTF + hn * 65536 + 2048 * c - (size_t)SC_NC * 16;
#pragma unroll
    for (int i = 0; i < 5; ++i) { const int p = lt + 448 * i; r[i] = gload16((p < SC_NC ? a : b) + (size_t)p * 16); }
}
#define SCAN_WAIT(r, N) asm volatile("s_waitcnt vmcnt(" #N ")" : "+v"(r[0]), "+v"(r[1]), "+v"(r[2]), "+v"(r[3]), "+v"(r[4]) :: "memory")
DI void scan_commit(const u32x4 (&r)[5], LAS unsigned char* buf, int lt) {
#pragma unroll
    for (int i = 0; i < 5; ++i) *(LAS u32x4*)(buf + (lt + 448 * i) * 16) = r[i];
}
DI void gla_scan_block(int h, int c, const unsigned char* CHK, const unsigned char* VTF, unsigned char* SPF, float* outS, LAS unsigned char* scr, int tid) {
    const int wave = tid >> 6, lane = tid & 63, l15 = lane & 15, quad = lane >> 4;
    LAS unsigned char* buf0 = scr; LAS unsigned char* buf1 = scr + SC_BUF;
    const size_t hn0 = (size_t)h * 128;
    if (wave >= 1) {
        const int lt = tid - 64;
        u32x4 r0[5], r1[5], r2[5], r3[5], r4[5], r5[5], r6[5], r7[5];
        scan_issue(r0, CHK, VTF, hn0, c, lt); SCAN_WAIT(r0, 0); scan_commit(r0, buf0, lt);
        scan_issue(r0, CHK, VTF, hn0 + 1, c, lt); scan_issue(r1, CHK, VTF, hn0 + 2, c, lt); scan_issue(r2, CHK, VTF, hn0 + 3, c, lt); scan_issue(r3, CHK, VTF, hn0 + 4, c, lt);
        scan_issue(r4, CHK, VTF, hn0 + 5, c, lt); scan_issue(r5, CHK, VTF, hn0 + 6, c, lt); scan_issue(r6, CHK, VTF, hn0 + 7, c, lt); scan_issue(r7, CHK, VTF, hn0 + 8, c, lt);
        __syncthreads();
#define SCAN_STEP(r, buf, nn) do { SCAN_WAIT(r, 35); scan_commit(r, buf, lt); { const int n5 = (nn) < 128 ? (nn) : 127; scan_issue(r, CHK, VTF, hn0 + n5, c, lt); } __syncthreads(); } while (0)
        for (int n = 0; n < 128; n += 8) {
            SCAN_STEP(r0, buf1, n + 9);
            SCAN_STEP(r1, buf0, n + 10);
            SCAN_STEP(r2, buf1, n + 11);
            SCAN_STEP(r3, buf0, n + 12);
            SCAN_STEP(r4, buf1, n + 13);
            SCAN_STEP(r5, buf0, n + 14);
            SCAN_STEP(r6, buf1, n + 15);
            SCAN_STEP(r7, buf0, n + 16);
        }
#undef SCAN_STEP
        SCAN_WAIT(r0, 0); SCAN_WAIT(r1, 0); SCAN_WAIT(r2, 0); SCAN_WAIT(r3, 0); SCAN_WAIT(r4, 0); SCAN_WAIT(r5, 0); SCAN_WAIT(r6, 0); SCAN_WAIT(r7, 0);
    } else {
        f32x4 S[16];
#pragma unroll
        for (int kt = 0; kt < 16; ++kt) S[kt] = (f32x4){0.f, 0.f, 0.f, 0.f};
        __syncthreads();
        unsigned char* sp_out = SPF + ((hn0 * 32 + c) * 8) * 1024 + lane * 16;
        for (int n = 0; n < 128; ++n) {
            const LAS unsigned char* buf = (n & 1) ? buf1 : buf0;
#define SC_SB() __builtin_amdgcn_sched_barrier(0)
#define SC_LK(f, dcv, q) do { _Pragma("unroll") for (int i = 0; i < 8; ++i) f[i] = *(const LAS bf16x8*)(buf + SC_KD + ((8 * (q) + i) * 64 + lane) * 16); \
        _Pragma("unroll") for (int i = 0; i < 4; ++i) dcv[i] = *(const LAS f32x4*)(buf + SC_DEC + (16 * (4 * (q) + i) + 4 * quad) * 4); } while (0)
#define SC_MU(f, dcv, q) do { _Pragma("unroll") for (int i = 0; i < 4; ++i) S[4 * (q) + i] = MFMA16(f[2 * i], v0, S[4 * (q) + i] * dcv[i]); \
        _Pragma("unroll") for (int i = 0; i < 4; ++i) S[4 * (q) + i] = MFMA16(f[2 * i + 1], v1, S[4 * (q) + i]); } while (0)
            bf16x8 fa[8], fb[8]; f32x4 da[4], db[4];
            SC_LK(fa, da, 0); SC_LK(fb, db, 1);
            const bf16x8 v0 = *(const LAS bf16x8*)(buf + SC_VT + lane * 16), v1 = *(const LAS bf16x8*)(buf + SC_VT + (64 + lane) * 16);
#pragma unroll
            for (int st = 0; st < 8; ++st) {
                u32x4 pw; pw.x = pkbf(S[2 * st][0], S[2 * st][1]); pw.y = pkbf(S[2 * st][2], S[2 * st][3]); pw.z = pkbf(S[2 * st + 1][0], S[2 * st + 1][1]); pw.w = pkbf(S[2 * st + 1][2], S[2 * st + 1][3]);
                *(u32x4*)(sp_out + (size_t)n * (32 * 8 * 1024) + st * 1024) = pw;
            }
            SC_SB(); SC_MU(fa, da, 0); SC_SB(); SC_LK(fa, da, 2);
            SC_SB(); SC_MU(fb, db, 1); SC_SB(); SC_LK(fb, db, 3);
            SC_SB(); SC_MU(fa, da, 2);
            SC_SB(); SC_MU(fb, db, 3);
#undef SC_SB
#undef SC_LK
#undef SC_MU
            __syncthreads();
        }
        float* sp = outS + (size_t)h * 256 * 512 + 16 * c + l15;
#pragma unroll
        for (int kt = 0; kt < 16; ++kt)
#pragma unroll
            for (int r = 0; r < 4; ++r) sp[(size_t)(16 * kt + 4 * quad + r) * 512] = S[kt][r];
    }
}

DI void gla_sample_unit(int b, int h, const bf16* PROJ, const float* w_a_up, const float* b_a, const float* g_gla, const float* st0, float* stN, bf16* MIX, LAS unsigned char* scr, int tid) {
    LAS float* qgS = (LAS float*)scr; LAS float* kgS = qgS + 1024; LAS float* kdS = kgS + 1024; LAS float* decS = kdS + 1024; LAS float* vS = decS + 256;
    LAS float* AS = vS + 2048; LAS float* part = AS + 64; LAS float* red = part + 8192;
    const size_t row0 = (size_t)TP + 4 * b;
    const int grp = tid >> 7, c = tid & 127;
    const size_t sb = ((size_t)(b * 4 + h) * 256 + 64 * grp) * 512 + 4 * c;
    f32x4 sA[16], sB[16];
#pragma unroll
    for (int i = 0; i < 16; ++i) sA[i] = __builtin_nontemporal_load((const f32x4*)(st0 + sb + (size_t)i * 512));
    if (tid < 256) {
        const int k = tid, col = h * 256 + k;
        float z[4];
#pragma unroll
        for (int t = 0; t < 4; ++t) z[t] = b_a[col];
#pragma unroll
        for (int r = 0; r < 16; ++r) { const float w = w_a_up[r * 1024 + col];
#pragma unroll
            for (int t = 0; t < 4; ++t) z[t] += bf2f(PROJ[(row0 + t) * NINP + PC_GA + r]) * w; }
        float bt[4], bs = 0.f;
#pragma unroll
        for (int t = 0; t < 4; ++t) { bs += logsig16(z[t]); bt[t] = bs; }
#pragma unroll
        for (int t = 0; t < 4; ++t) {
            const float qv = bf2f(PROJ[(row0 + t) * NINP + PC_GQ + col]) * 0.0625f, kv = bf2f(PROJ[(row0 + t) * NINP + PC_GK + col]);
            qgS[t * 256 + k] = qv * __expf(bt[t]); kgS[t * 256 + k] = kv * __expf(-bt[t]); kdS[t * 256 + k] = kv * __expf(bs - bt[t]);
        }
        decS[k] = __expf(bs);
    } else {
        const int tt = tid - 256;
#pragma unroll
        for (int i = 0; i < 8; ++i) { const int idx = tt + 256 * i; vS[idx] = bf2f(PROJ[(row0 + (idx >> 9)) * NINP + PC_GV + h * 512 + (idx & 511)]); }
    }
    __syncthreads();
    const int wave = tid >> 6, lane = tid & 63;
    for (int p = wave; p < 10; p += 8) {
        const int t = (p >= 6) ? 3 : (p >= 3) ? 2 : (p >= 1) ? 1 : 0, s = p - (t * (t + 1)) / 2;
        float a = 0.f;
#pragma unroll
        for (int i = 0; i < 4; ++i) a += qgS[t * 256 + lane + 64 * i] * kgS[s * 256 + lane + 64 * i];
        a = wave_sum(a);
        if (lane == 0) AS[t * 4 + s] = a;
    }
    __syncthreads();
    f32x4 vv[4], oa[4];
#pragma unroll
    for (int t = 0; t < 4; ++t) { vv[t] = *(const LAS f32x4*)(vS + t * 512 + 4 * c); oa[t] = (f32x4){0.f, 0.f, 0.f, 0.f}; }
#define GS_LOAD(buf, k0) do { _Pragma("unroll") for (int i = 0; i < 16; ++i) buf[i] = __builtin_nontemporal_load((const f32x4*)(st0 + sb + (size_t)((k0) + i) * 512)); } while (0)
#define GS_STEP(buf, k0) do { _Pragma("unroll") for (int i = 0; i < 16; ++i) { const int k = 64 * grp + (k0) + i; f32x4 sn = buf[i] * decS[k]; \
        _Pragma("unroll") for (int t = 0; t < 4; ++t) { sn += vv[t] * kdS[t * 256 + k]; oa[t] += buf[i] * qgS[t * 256 + k]; } \
        __builtin_nontemporal_store(sn, (f32x4*)(stN + sb + (size_t)((k0) + i) * 512)); } } while (0)
    GS_LOAD(sB, 16); GS_STEP(sA, 0);
    GS_LOAD(sA, 32); GS_STEP(sB, 16);
    GS_LOAD(sB, 48); GS_STEP(sA, 32);
    GS_STEP(sB, 48);
#undef GS_LOAD
#undef GS_STEP
#pragma unroll
    for (int t = 0; t < 4; ++t) *(LAS f32x4*)(part + (grp * 4 + t) * 512 + 4 * c) = oa[t];
    __syncthreads();
    {
        const int t = tid >> 7;
        f32x4 o = (f32x4){0.f, 0.f, 0.f, 0.f};
#pragma unroll
        for (int g = 0; g < 4; ++g) o += *(const LAS f32x4*)(part + (g * 4 + t) * 512 + 4 * c);
        for (int s = 0; s <= t; ++s) o += *(const LAS f32x4*)(vS + s * 512 + 4 * c) * AS[t * 4 + s];
        float ss = wave_sum((o.x * o.x + o.y * o.y) + (o.z * o.z + o.w * o.w));
        if (lane == 0) red[wave] = ss;
        __syncthreads();
        const float rstd = 1.0f / sqrtf((red[2 * t] + red[2 * t + 1]) * (1.0f / 512.0f) + NORM_EPS);
        const f32x4 gg = *(const f32x4*)(g_gla + 4 * c);
        const u32x2 gr = *(const u32x2*)(PROJ + (row0 + t) * NINP + PC_GR + h * 512 + 4 * c);
        const f32x4 r4 = (f32x4){silu_f(bflo(gr.x)), silu_f(bfhi(gr.x)), silu_f(bflo(gr.y)), silu_f(bfhi(gr.y))};
        const f32x4 y = (o * rstd) * gg * r4;
        u32x2 w; w.x = pkbf(y.x, y.y); w.y = pkbf(y.z, y.w);
        *(u32x2*)(MIX + (row0 + t) * D + h * 512 + 4 * c) = w;
    }
    __syncthreads();
}

DI void gla_out_unit(int n, int h, const unsigned char* CHK, const unsigned char* SPF, const bf16* OIA, const bf16* PROJ, const float* g_gla, bf16* MIX, LAS unsigned char* scr, int tid) {
    const int wave = tid >> 6, lane = tid & 63, l15 = lane & 15, quad = lane >> 4;
    const size_t hn = (size_t)h * 128 + n, row0 = (size_t)64 * n;
    LAS float* red = (LAS float*)(scr + 32768);
    bf16x8 af[4][4], ag[4][4];
    const unsigned char* sp = SPF + ((hn * 32 + 4 * wave) * 8) * 1024 + lane * 16;
#pragma unroll
    for (int vt = 0; vt < 4; ++vt)
#pragma unroll
        for (int st = 0; st < 4; ++st) { af[vt][st] = *(const bf16x8*)(sp + (vt * 8 + st) * 1024); ag[vt][st] = *(const bf16x8*)(sp + (vt * 8 + 4 + st) * 1024); }
#pragma unroll
    for (int i = 0; i < 4; ++i) { const int p = tid + 512 * i; *(LAS u32x4*)(scr + p * 16) = *(const u32x4*)(CHK + hn * CHK_BYTES + (size_t)p * 16); }
    __syncthreads();
    f32x4 acc[4][4];
#pragma unroll
    for (int vt = 0; vt < 4; ++vt)
#pragma unroll
        for (int mt = 0; mt < 4; ++mt) acc[vt][mt] = (f32x4){0.f, 0.f, 0.f, 0.f};
#pragma unroll
    for (int st = 0; st < 8; ++st) {
        bf16x8 bq[4];
#pragma unroll
        for (int mt = 0; mt < 4; ++mt) bq[mt] = *(const LAS bf16x8*)(scr + ((mt * 8 + st) * 64 + lane) * 16);
#pragma unroll
        for (int vt = 0; vt < 4; ++vt)
#pragma unroll
            for (int mt = 0; mt < 4; ++mt) acc[vt][mt] = MFMA16(st < 4 ? af[vt][st & 3] : ag[vt][st & 3], bq[mt], acc[vt][mt]);
    }
    float ss[4];
#pragma unroll
    for (int mt = 0; mt < 4; ++mt) {
        const bf16* op = OIA + (row0 + 16 * mt + l15) * 2048 + h * 512 + 64 * wave + 4 * quad;
        float s = 0.f;
#pragma unroll
        for (int vt = 0; vt < 4; ++vt) { acc[vt][mt] += ld4(op + 16 * vt); const f32x4 o = acc[vt][mt]; s += (o.x * o.x + o.y * o.y) + (o.z * o.z + o.w * o.w); }
        s += __shfl_xor(s, 16); s += __shfl_xor(s, 32);
        ss[mt] = s;
        if (quad == 0) red[wave * 64 + 16 * mt + l15] = s;
    }
    __syncthreads();
#pragma unroll
    for (int mt = 0; mt < 4; ++mt) {
        float tot = 0.f;
#pragma unroll
        for (int w = 0; w < 8; ++w) tot += red[w * 64 + 16 * mt + l15];
        const float rstd = 1.0f / sqrtf(tot * (1.0f / 512.0f) + NORM_EPS);
        const size_t row = row0 + 16 * mt + l15;
#pragma unroll
        for (int vt = 0; vt < 4; ++vt) {
            const int col = h * 512 + 64 * wave + 16 * vt + 4 * quad;
            const f32x4 gg = *(const f32x4*)(g_gla + 64 * wave + 16 * vt + 4 * quad);
            const u32x2 gr = *(const u32x2*)(PROJ + row * NINP + PC_GR + col);
            const f32x4 r4 = (f32x4){silu_f(bflo(gr.x)), silu_f(bfhi(gr.x)), silu_f(bflo(gr.y)), silu_f(bfhi(gr.y))};
            const f32x4 y = (acc[vt][mt] * rstd) * gg * r4;
            u32x2 w; w.x = pkbf(y.x, y.y); w.y = pkbf(y.z, y.w);
            *(u32x2*)(MIX + row * D + col) = w;
        }
    }
    (void)ss;
    __syncthreads();
}

DI void stagger_start(int bid, unsigned ticks) {
    const unsigned long long t0 = __builtin_amdgcn_s_memrealtime(), dly = (unsigned long long)((bid >> 3) & 31) * ticks;
    while (__builtin_amdgcn_s_memrealtime() - t0 < dly) __builtin_amdgcn_s_sleep(2);
}

struct CRow { f32x4 g[2], v[2]; };
DI CRow crow_bf16i(const bf16* p) { const u32x4 a = *(const u32x4*)p, c = *(const u32x4*)(p + 128); CRow r;
    r.g[0] = (f32x4){bflo(a.x), bfhi(a.x), bflo(a.y), bfhi(a.y)}; r.g[1] = (f32x4){bflo(a.z), bfhi(a.z), bflo(a.w), bfhi(a.w)};
    r.v[0] = (f32x4){bflo(c.x), bfhi(c.x), bflo(c.y), bfhi(c.y)}; r.v[1] = (f32x4){bflo(c.z), bfhi(c.z), bflo(c.w), bfhi(c.w)}; return r; }
DI CRow crow_f32(const float* p) { CRow r; r.g[0] = *(const f32x4*)p; r.g[1] = *(const f32x4*)(p + 4); r.v[0] = *(const f32x4*)(p + FF); r.v[1] = *(const f32x4*)(p + FF + 4); return r; }
DI CRow crow_zero() { CRow r; r.g[0] = r.g[1] = r.v[0] = r.v[1] = (f32x4){0.f, 0.f, 0.f, 0.f}; return r; }
struct CTaps { f32x4 wg[3][2], wv[3][2], bg[2], bv[2]; };
DI CTaps ctaps_load(const float* wc, const float* bc, int f) { CTaps t;
#pragma unroll
    for (int hh = 0; hh < 2; ++hh) {
#pragma unroll
        for (int j = 0; j < 3; ++j) { t.wg[j][hh] = *(const f32x4*)(wc + (size_t)j * F2 + f + 4 * hh); t.wv[j][hh] = *(const f32x4*)(wc + (size_t)j * F2 + FF + f + 4 * hh); }
        t.bg[hh] = *(const f32x4*)(bc + f + 4 * hh); t.bv[hh] = *(const f32x4*)(bc + FF + f + 4 * hh);
    }
    return t; }
DI float silu_r(float x) { return x * __builtin_amdgcn_rcpf(1.0f + __expf(-x)); }
DI void conv_half(const CTaps& t, int hh, const f32x4& p2g, const f32x4& p1g, const f32x4& cg, const f32x4& p2v, const f32x4& p1v, const f32x4& cv, unsigned& w0, unsigned& w1) {
    const f32x4 g = t.bg[hh] + t.wg[0][hh] * p2g + t.wg[1][hh] * p1g + t.wg[2][hh] * cg;
    const f32x4 v = t.bv[hh] + t.wv[0][hh] * p2v + t.wv[1][hh] * p1v + t.wv[2][hh] * cv;
    w0 = pkbf(silu_r(g.x) * v.x, silu_r(g.y) * v.y); w1 = pkbf(silu_r(g.z) * v.z, silu_r(g.w) * v.w);
}
DI u32x4 conv_out(const CTaps& t, const CRow& p2, const CRow& p1, const CRow& c) { u32x4 w; unsigned* wp = (unsigned*)&w;
#pragma unroll
    for (int hh = 0; hh < 2; ++hh) conv_half(t, hh, p2.g[hh], p1.g[hh], c.g[hh], p2.v[hh], p1.v[hh], c.v[hh], wp[2 * hh], wp[2 * hh + 1]);
    return w; }
DI float dpp_shr1(float x) { return __builtin_bit_cast(float, __builtin_amdgcn_update_dpp(0, __builtin_bit_cast(int, x), 0x111, 0xf, 0xf, true)); }
DI float dpp_shr2(float x) { return __builtin_bit_cast(float, __builtin_amdgcn_update_dpp(0, __builtin_bit_cast(int, x), 0x112, 0xf, 0xf, true)); }
DI float dpp_shr1w(float prev, float x) { return __builtin_bit_cast(float, __builtin_amdgcn_update_dpp(__builtin_amdgcn_update_dpp(0, __builtin_bit_cast(int, prev), 0x121, 0xf, 0xf, true), __builtin_bit_cast(int, x), 0x111, 0xf, 0xf, false)); }
DI float dpp_shr2w(float prev, float x) { return __builtin_bit_cast(float, __builtin_amdgcn_update_dpp(__builtin_amdgcn_update_dpp(0, __builtin_bit_cast(int, prev), 0x122, 0xf, 0xf, true), __builtin_bit_cast(int, x), 0x112, 0xf, 0xf, false)); }
DI f32x4 dpp_shr1w(f32x4 p, f32x4 x) { return (f32x4){dpp_shr1w(p[0], x[0]), dpp_shr1w(p[1], x[1]), dpp_shr1w(p[2], x[2]), dpp_shr1w(p[3], x[3])}; }
DI f32x4 dpp_shr2w(f32x4 p, f32x4 x) { return (f32x4){dpp_shr2w(p[0], x[0]), dpp_shr2w(p[1], x[1]), dpp_shr2w(p[2], x[2]), dpp_shr2w(p[3], x[3])}; }
DI f32x4 dpp_shr1(f32x4 x) { return (f32x4){dpp_shr1(x[0]), dpp_shr1(x[1]), dpp_shr1(x[2]), dpp_shr1(x[3])}; }
DI f32x4 dpp_shr2(f32x4 x) { return (f32x4){dpp_shr2(x[0]), dpp_shr2(x[1]), dpp_shr2(x[2]), dpp_shr2(x[3])}; }
DI u32x4 pack8(const f32x4& a, const f32x4& b) { u32x4 w; w.x = pkbf(a[0], a[1]); w.y = pkbf(a[2], a[3]); w.z = pkbf(b[0], b[1]); w.w = pkbf(b[2], b[3]); return w; }
struct EpiConv {
    static constexpr bool PERM = true, AFTER_DRAIN = false;
    bf16* Gm; bf16* UE; bf16* US; const float* wc; const float* bc; float* ocp;
    DI void operator()(const f32x4 (&acc)[2][2][4][2], const pg8::Unit& u, int wr, int wcol, int fr, int fq) const {
        const int cw = wcol * 32 + 8 * fq, ucol = 256 * u.pn + cw, f = 128 * u.pn + cw, rowb = u.pm * 256 + wr * 64 + fr;
        if (u.pm >= 32) {
#pragma unroll
            for (int ai = 0; ai < 2; ++ai)
#pragma unroll
                for (int m = 0; m < 4; ++m) { bf16* rp = US + (size_t)(rowb + 128 * ai + 16 * m - TP) * F2 + ucol;
                    *(u32x4*)rp = pack8(acc[ai][0][m][0], acc[ai][0][m][1]); *(u32x4*)(rp + 128) = pack8(acc[ai][1][m][0], acc[ai][1][m][1]); }
            return;
        }
        const CTaps t = ctaps_load(wc, bc, f);
        const int slot = fr < 2 ? fr : fr - 12;
#pragma unroll
        for (int ai = 0; ai < 2; ++ai)
#pragma unroll
            for (int m = 0; m < 4; ++m) {
                const int row = rowb + 128 * ai + 16 * m;
                u32x4 w; unsigned* wp = (unsigned*)&w;
#pragma unroll
                for (int hh = 0; hh < 2; ++hh) { const f32x4 cg = acc[ai][0][m][hh], cv = acc[ai][1][m][hh];
                    if (m == 0) conv_half(t, hh, dpp_shr2(cg), dpp_shr1(cg), cg, dpp_shr2(cv), dpp_shr1(cv), cv, wp[2 * hh], wp[2 * hh + 1]);
                    else { const f32x4 qg = acc[ai][0][m - 1][hh], qv = acc[ai][1][m - 1][hh];
                        conv_half(t, hh, dpp_shr2w(qg, cg), dpp_shr1w(qg, cg), cg, dpp_shr2w(qv, cv), dpp_shr1w(qv, cv), cv, wp[2 * hh], wp[2 * hh + 1]); }
                    __builtin_amdgcn_sched_barrier(0); }
                *(u32x4*)(Gm + (size_t)row * FF + f) = w;
                if ((m == 0 && fr < 2) || (m == 3 && fr >= 14)) { bf16* ep = UE + ((size_t)(row >> 6) * 4 + slot) * F2 + ucol; *(u32x4*)ep = pack8(acc[ai][0][m][0], acc[ai][0][m][1]); *(u32x4*)(ep + 128) = pack8(acc[ai][1][m][0], acc[ai][1][m][1]); }
                if (row >= TP - 2) { float* oc = ocp + (size_t)(row - (TP - 2)) * F2 + f; *(f32x4*)oc = acc[ai][0][m][0]; *(f32x4*)(oc + 4) = acc[ai][0][m][1]; *(f32x4*)(oc + FF) = acc[ai][1][m][0]; *(f32x4*)(oc + FF + 4) = acc[ai][1][m][1]; }
            }
    }
};
struct CRaw { u32x4 a, c; };
DI CRaw craw_ld(const bf16* p) { CRaw r; r.a = *(const u32x4*)p; r.c = *(const u32x4*)(p + 128); return r; }
DI CRow crow_cvt(const CRaw& q) { CRow r; const u32x4 a = q.a, c = q.c;
    r.g[0] = (f32x4){bflo(a.x), bfhi(a.x), bflo(a.y), bfhi(a.y)}; r.g[1] = (f32x4){bflo(a.z), bfhi(a.z), bflo(a.w), bfhi(a.w)};
    r.v[0] = (f32x4){bflo(c.x), bfhi(c.x), bflo(c.y), bfhi(c.y)}; r.v[1] = (f32x4){bflo(c.z), bfhi(c.z), bflo(c.w), bfhi(c.w)}; return r; }
DI void conv_fix4(int strip, int g0, const bf16* UE, const float* wc, const float* bc, bf16* G, int lane) {
    const int f = 512 * strip + 8 * lane;
    if (f >= FF) return;
    const int ucol = 256 * (f >> 7) + (f & 127);
    const CTaps t = ctaps_load(wc, bc, f);
    CRow p2 = g0 ? crow_bf16i(UE + ((size_t)(g0 - 1) * 4 + 2) * F2 + ucol) : crow_zero();
    CRow p1 = g0 ? crow_bf16i(UE + ((size_t)(g0 - 1) * 4 + 3) * F2 + ucol) : crow_zero();
#pragma unroll 1
    for (int h = 0; h < 4; ++h) {
        CRaw e[4];
#pragma unroll
        for (int s = 0; s < 4; ++s) e[s] = craw_ld(UE + ((size_t)(g0 + h) * 4 + s) * F2 + ucol);
        const int r = 64 * (g0 + h);
        const CRow c0 = crow_cvt(e[0]), c1 = crow_cvt(e[1]);
        *(u32x4*)(G + (size_t)r * FF + f) = conv_out(t, p2, p1, c0);
        *(u32x4*)(G + (size_t)(r + 1) * FF + f) = conv_out(t, p1, c0, c1);
        p2 = crow_cvt(e[2]); p1 = crow_cvt(e[3]);
    }
}
DI void conv_sample(int strip, int b, const bf16* US, const float* st, const float* wc, const float* bc, bf16* G, float* o0, float* o1, int lane) {
    const int f = 512 * strip + 8 * lane;
    if (f >= FF) return;
    const int ucol = 256 * (f >> 7) + (f & 127);
    const CTaps t = ctaps_load(wc, bc, f);
    CRow p2 = crow_f32(st + f), p1 = crow_f32(st + F2 + f), cu[4];
#pragma unroll
    for (int i = 0; i < 4; ++i) cu[i] = crow_bf16i(US + (size_t)(4 * b + i) * F2 + ucol);
#pragma unroll
    for (int i = 0; i < 4; ++i) {
        *(u32x4*)(G + (size_t)(TP + 4 * b + i) * FF + f) = conv_out(t, p2, p1, cu[i]);
        p2 = p1; p1 = cu[i];
    }
    *(f32x4*)(o0 + f) = cu[2].g[0]; *(f32x4*)(o0 + f + 4) = cu[2].g[1]; *(f32x4*)(o0 + FF + f) = cu[2].v[0]; *(f32x4*)(o0 + FF + f + 4) = cu[2].v[1];
    *(f32x4*)(o1 + f) = cu[3].g[0]; *(f32x4*)(o1 + f + 4) = cu[3].g[1]; *(f32x4*)(o1 + FF + f) = cu[3].v[0]; *(f32x4*)(o1 + FF + f + 4) = cu[3].v[1];
}

__global__ void __launch_bounds__(NWAVES * 64, 2) hymba_fwd(Args args) {
    extern __shared__ __attribute__((aligned(16))) unsigned char lds_raw[];
    LAS unsigned char* lds = (LAS unsigned char*)lds_raw;
    const int tid = threadIdx.x, lane = tid & 63, wave = __builtin_amdgcn_readfirstlane(tid >> 6);
    const int G = gridDim.x, bid = blockIdx.x;
    unsigned char* ws = args.ws;
    unsigned* ctl = (unsigned*)(ws + WS_CTL);
    for (int u = tid; u < LDS_SCR / 4; u += NWAVES * 64) ((LAS unsigned*)lds)[u] = 0u;
    __syncthreads();
    XcdBarrier bar = xcd_barrier_post(ctl + CW_BAR + args.li * XCD_BAR_WORDS, (volatile LAS unsigned*)lds + 8);
    LAS unsigned char* scr = lds + LDS_SCR;
    const int gw = bid * NWAVES + wave, NGW = G * NWAVES;

    const float* xp = args.in[I_XP]; const float* xs = args.in[I_XS];
    float* MOD = (float*)(ws + WS_MOD);
    bf16* WIN = (bf16*)(ws + WS_WIN); bf16* WO = (bf16*)(ws + WS_WO); bf16* WUP = (bf16*)(ws + WS_WUP); bf16* WDN = (bf16*)(ws + WS_WDN);
    bf16* X1 = (bf16*)(ws + WS_X1); bf16* X2 = (bf16*)(ws + WS_X2); bf16* H = (bf16*)(ws + WS_H); bf16* MIX = (bf16*)(ws + WS_MIX); bf16* PROJ = (bf16*)(ws + WS_PROJ);
    unsigned char* CHK = ws + WS_CHK; unsigned char* VTF = ws + WS_VTF;
    bf16* OIA = (bf16*)(ws + WS_OIA); unsigned char* SPF = ws + WS_SPF; bf16* UE = (bf16*)(ws + WS_UE); bf16* US = (bf16*)(ws + WS_US); bf16* GB = (bf16*)(ws + WS_G);
    float* out = args.out; bf16* SLAB = (bf16*)(ws + WS_SLAB);

    const int lo = args.ph_lo, hi = args.ph_hi;
#define IN(k) (lo <= (k) && (k) < hi)
#define SEAM(k) do { if (IN(k) && IN((k) + 1)) xcd_barrier(bar); } while (0)

    if (IN(0)) {
        if (bid < 192) adaln_block(8 * bid, args.in[I_CS], args.in[I_CP], args.in[I_WADA], args.in[I_BADA], MOD, scr, opq(tid));
        LAS unsigned char* ws_scr = scr + wave * 8192;
        constexpr int I_I = 64 * (NINP / 64), I_O = 64 * 64;
        constexpr int NIT = I_I + I_O, BATCH = 32;
        for (int rnd = 0;; ++rnd) {
            volatile LAS unsigned* slot = (volatile LAS unsigned*)lds + 16 + (rnd & 1);
            if (tid == 0) *slot = __hip_atomic_fetch_add(ctl + CW_WORK, (unsigned)BATCH, __ATOMIC_RELAXED, __HIP_MEMORY_SCOPE_AGENT);
            __syncthreads();
            const int base = (int)*slot;
            if (base >= NIT) break;
#pragma unroll 1
            for (int it = base + wave; it < base + BATCH && it < NIT; it += NWAVES) {
                if (it < I_I) tr_win(args.in[I_WIN], WIN, it, ws_scr, opq(lane));
                else tr_plain(args.in[I_WO], D, D, WO, it - I_I, ws_scr, opq(lane));
            }
        }
    }
    if (IN(0) && IN(2)) xcd_barrier(bar);
    if (IN(2)) {
        for (int pr = bid; pr < TS / 2; pr += G)
            sample_pair<0>(pr, xs, MOD, 0, nullptr, nullptr, args.in[I_GNORM], D, 0, H + (size_t)TP * D, nullptr, (LAS float*)scr + 32, opq(tid));
        for (int r = gw; r < TP; r += NGW) { const float* m = MOD + (size_t)128 * NMOD; modnorm_row(xp + (size_t)r * D, args.in[I_GNORM], m + 4096, m, H + (size_t)r * D, opq(lane)); }
    }
    SEAM(2);
    if (IN(3)) {
        pg8::Gemm g{H, WIN, MROWS, NINP, D}; pg8::StaticOrder S; S.init(MROWS, NINP, G, bid, D);
        pg8::EpiBf16 E{PROJ, NINP};
        pg8::gemm_phase<pg8::EpiBf16, pg8::StaticOrder, true, true>(scr, g, S, E);
    }
    SEAM(3);
    if (IN(4)) {
        for (int rnd = 0;; ++rnd) {
            volatile LAS unsigned* slot = (volatile LAS unsigned*)lds + 16 + (rnd & 1);
            if (tid == 0) *slot = __hip_atomic_fetch_add(ctl + CW_WORK4 + 16 * args.li, 1u, __ATOMIC_RELAXED, __HIP_MEMORY_SCOPE_AGENT);
            __syncthreads();
            const int id = (int)*slot;
            if (id >= 1024) break;
            if (id >= 128 && id < 640) { const int u = id - 128; if (!(args.pad & 4)) gla_local_unit(u & 127, u >> 7, PROJ, args.in[I_WAUP], args.in[I_BA], CHK, VTF, OIA, scr, opq(tid), (args.pad >> 4) & 7); }
            else { const int u = id < 128 ? id : id - 512; if (!(args.pad & 8)) gla_sample_unit(u >> 2, u & 3, PROJ, args.in[I_WAUP], args.in[I_BA], args.in[I_GGLA], args.in[I_SGLA], out + O_GLA_S, MIX, scr, opq(tid)); }
        }
    }
    SEAM(4);
    if (IN(5)) {
        if (bid < 128) { if (!(args.pad & 1)) {
            const int x = bid & 7, i = bid >> 3;
            gla_scan_block(x >> 1, (x & 1) * 16 + i, CHK, VTF, SPF, out + O_GLA_P, scr, opq(tid)); __syncthreads(); }
        }
        constexpr int NB_U = (64 * (F2 / 64)) / (2 * NWAVES), NCOPY = 64;
        int stage = (bid >= 128 && bid < 128 + NCOPY) ? 1 : 0, left = 2;
        if (!(args.pad & 2)) for (int rnd = 0;; ++rnd) {
            volatile LAS unsigned* slot = (volatile LAS unsigned*)lds + 16 + (rnd & 1);
            if (tid == 0) *slot = __hip_atomic_fetch_add(ctl + (stage ? CW_WORK5B : CW_WORK5) + 16 * args.li, 1u, __ATOMIC_RELAXED, __HIP_MEMORY_SCOPE_AGENT);
            __syncthreads();
            const int id = (int)*slot;
            if (id >= (stage ? NB_U : 768)) { if (--left == 0) break; stage ^= 1; continue; }
            if (stage == 0) {
                const int unit = id;
                if (args.pad & 128) {} else
                if (unit < 256) swa_prompt_unit(unit >> 2, unit & 3, PROJ, args.in[I_SINK], MIX, out + O_K_P, out + O_V_P, scr, opq(tid));
                else { const int u = unit - 256; swa_sample_unit(u >> 2, u & 3, PROJ, args.in[I_SK], args.in[I_SV], args.in[I_SINK], MIX, out + O_K_S, out + O_V_S, scr, opq(tid)); }
            } else {
                const int cb = id;
                if (!(args.pad & 256)) tr_wup2(args.in[I_WUP], WUP, cb * 2 * NWAVES + wave, cb * 2 * NWAVES + NWAVES + wave, scr + wave * 8192, opq(lane));
                __syncthreads();
            }
        }
    }
    SEAM(5);
    if (IN(6)) {
        for (int u = bid; u < 512; u += G) gla_out_unit(u & 127, u >> 7, CHK, SPF, OIA, PROJ, args.in[I_GGLA], MIX, scr, opq(tid));
    }
    SEAM(6);
    if (IN(7)) {
        pg8::Gemm g{MIX, WO, MROWS, D, D}; pg8::TailOrder S; S.init(G, bid, D);
        pg8::EpiResid<false> E{xp, MOD + 2 * D, X1, SLAB, D / 128};
        pg8::gemm_phase<pg8::EpiResid<false>, pg8::TailOrder, true, true>(scr, g, S, E);
    }
    SEAM(7);
    if (IN(8)) {
        for (int pr = bid; pr < TS / 2; pr += G)
            sample_pair<1>(pr, xs, MOD, 2 * D, SLAB, X1 + (size_t)TP * D, args.in[I_GNORM] + D, 4 * D, 3 * D, H + (size_t)TP * D, nullptr, (LAS float*)scr + 32, opq(tid));
        for (int r = gw; r < TP; r += NGW) { const float* m = MOD + (size_t)128 * NMOD; modnorm_row(X1 + (size_t)r * D, args.in[I_GNORM] + D, m + 4 * D, m + 3 * D, H + (size_t)r * D, opq(lane)); }
    }
    SEAM(8);
    if (IN(9)) {
        constexpr int GG = 244;
        if (bid < GG || G <= GG) {
            pg8::Gemm g{H, WUP, MROWS, F2, D}; pg8::StaticOrder S; S.init(MROWS, F2, G <= GG ? G : GG, bid, D);
            EpiConv E{GB, UE, US, args.in[I_WCONV], args.in[I_BCONV], out + O_CONV_P};
            pg8::gemm_phase<EpiConv, pg8::StaticOrder, true, true>(scr, g, S, E);
        }
        if (bid >= GG || G <= GG) {
            LAS unsigned char* ws_scr = scr + wave * 8192;
            const int w0 = G <= GG ? gw : (bid - GG) * NWAVES + wave, nw = G <= GG ? NGW : (G - GG) * NWAVES;
#pragma unroll 1
            for (int it = w0; it < (FF / 64) * 64; it += nw) tr_plain(args.in[I_WDN], FF, D, WDN, it, ws_scr, opq(lane));
        }
    }
    SEAM(9);
    if (IN(10)) {
        for (int it = gw; it < 32 * 22 + 128 * 22; it += NGW) {
            if (it < 32 * 22) conv_fix4(it % 22, 4 * (it / 22), UE, args.in[I_WCONV], args.in[I_BCONV], GB, opq(lane));
            else { const int k = it - 32 * 22, b = k / 22, strip = k % 22;
                conv_sample(strip, b, US, args.in[I_SCONV] + (size_t)b * 2 * F2, args.in[I_WCONV], args.in[I_BCONV], GB, out + O_CONV_S + (size_t)b * 2 * F2, out + O_CONV_S + (size_t)(b * 2 + 1) * F2, opq(lane)); }
        }
    }
    SEAM(10);
    if (IN(11)) {
        pg8::Gemm g{GB, WDN, MROWS, D, FF}; pg8::TailOrder S; S.init(G, bid, FF);
        pg8::EpiResid<true> E{X1, MOD + 5 * D, X2, SLAB, FF / 128};
        pg8::gemm_phase<pg8::EpiResid<true>, pg8::TailOrder, true, true>(scr, g, S, E);
    }
    SEAM(11);
    if (IN(12)) {
        for (int pr = bid; pr < TS / 2; pr += G)
            sample_pair<2>(pr, X1 + (size_t)TP * D, MOD, 5 * D, SLAB, nullptr, args.in[I_GFIN], 0, 0, nullptr, out + O_Y + (size_t)TP * D, (LAS float*)scr + 32, opq(tid));
        for (int r = gw; r < TP; r += NGW) finalnorm_row(X2 + (size_t)r * D, out + O_Y + (size_t)r * D, args.in[I_GFIN], opq(lane));
    }
#undef IN
#undef SEAM
}

#ifndef MK_N_LAUNCHES
#define MK_N_LAUNCHES 1
#endif
extern "C" void kernel_launch(void* const* d_in, const int* in_sizes, int n_in, void* d_out, int out_size, void* d_ws, size_t ws_size, hipStream_t stream) {
    static int grid = 0;
    if (grid == 0) {
        if (n_in != 22 || (size_t)out_size != O_END || ws_size < WS_END) { fprintf(stderr, "kernel_launch: unexpected shapes (n_in %d, out %d, ws %zu); nothing launched\n", n_in, out_size, ws_size); grid = -1; return; }
        int dev = 0, cus = 0, per_cu = 0;
        if (hipGetDevice(&dev) != hipSuccess || hipDeviceGetAttribute(&cus, hipDeviceAttributeMultiprocessorCount, dev) != hipSuccess) { grid = -1; return; }
        if (hipFuncSetAttribute((const void*)hymba_fwd, hipFuncAttributeMaxDynamicSharedMemorySize, LDS_BYTES) != hipSuccess) { fprintf(stderr, "kernel_launch: hipFuncSetAttribute failed\n"); grid = -1; return; }
        if (hipOccupancyMaxActiveBlocksPerMultiprocessor(&per_cu, (const void*)hymba_fwd, NWAVES * 64, LDS_BYTES) != hipSuccess || per_cu < 1) { fprintf(stderr, "kernel_launch: occupancy query says %d\n", per_cu); }
        (void)hipGetLastError();
        grid = cus;
        if (grid < 128) { fprintf(stderr, "kernel_launch: %d CUs: this kernel is built for a 256-CU device\n", grid); grid = -1; return; }
    }
    if (grid < 0) return;
    (void)hipMemsetAsync((char*)d_ws + WS_CTL, 0, CTL_ZERO_BYTES, stream);
    Args a{};
    for (int i = 0; i < 22; ++i) a.in[i] = (const float*)d_in[i];
    a.out = (float*)d_out; a.ws = (unsigned char*)d_ws;
#if defined(PROBE_A)
#ifndef PROBE_PAD
#define PROBE_PAD 0
#endif
    const int cuts[3][2] = {{0, PROBE_B}, {PROBE_A, PROBE_B}, {PROBE_B, 13}};
    for (int li = 0; li < 3; ++li) { a.ph_lo = cuts[li][0]; a.ph_hi = cuts[li][1]; a.li = li; a.pad = (li == 1) ? PROBE_PAD : 0; if (a.ph_lo < a.ph_hi) hipLaunchKernelGGL(hymba_fwd, dim3(grid), dim3(NWAVES * 64), LDS_BYTES, stream, a); }
#else
    a.ph_lo = 0; a.ph_hi = 13; a.li = 0;
    hipLaunchKernelGGL(hymba_fwd, dim3(grid), dim3(NWAVES * 64), LDS_BYTES, stream, a);
#endif
}
```
